# Optimizing an MI355X kernel written in HIP

```python
import math
import jax, jax.numpy as jnp
from jax import lax
import numpy as np

D_MODEL = 1024
BATCH = 2
SEQ = 8192
DEPTH = 4

ATTN_HEADS = 8
ATTN_HEAD_DIM = 64
ATTN_QK_WIDTH = 2 * ATTN_HEADS * ATTN_HEAD_DIM
ATTN_V_WIDTH = ATTN_HEADS * 2 * ATTN_HEAD_DIM
Q_BLOCK = 128
GMLP_CHUNK = 128
GMLP_GROUPS = 8
GMLP_GROUP_DIM = 128
GMLP_WIDTH = GMLP_GROUPS * GMLP_GROUP_DIM
IN_WIDTH = 2 * ATTN_QK_WIDTH + ATTN_V_WIDTH + 2 * GMLP_WIDTH + 2 * D_MODEL
N_EXPERTS = 16
EXPERT_FF = 2 * D_MODEL
EC_CAPACITY = 2
NORM_EPS = 1e-6

kernel_name = 'hybrid_diffattn_gmlp_ecmoe_encoder'


def _rmsnorm(x, g):
    x32 = x.astype(jnp.float32)
    y = x32 * lax.rsqrt(jnp.mean(x32 * x32, axis=-1, keepdims=True) + NORM_EPS)
    return (y * g.astype(jnp.float32)).astype(x.dtype)


def _layernorm(x, g, b):
    x32 = x.astype(jnp.float32)
    mu = jnp.mean(x32, axis=-1, keepdims=True)
    xc = x32 - mu
    var = jnp.mean(xc * xc, axis=-1, keepdims=True)
    y = xc * lax.rsqrt(var + NORM_EPS) * g.astype(jnp.float32) + b.astype(jnp.float32)
    return y.astype(x.dtype)


def _alibi_slopes():
    return 2.0 ** (-8.0 * jnp.arange(1, ATTN_HEADS + 1, dtype=jnp.float32) / ATTN_HEADS)


def _diff_lambda(lq1, lk1, lq2, lk2, lam_init):
    f = lambda a: a.astype(jnp.float32)
    return jnp.exp(jnp.sum(f(lq1) * f(lk1))) - jnp.exp(jnp.sum(f(lq2) * f(lk2))) + lam_init


def _diff_attention(q, k, v, lam):
    B, S = q.shape[0], q.shape[1]
    nb = S // Q_BLOCK
    qb = jnp.moveaxis(q.reshape(B, nb, Q_BLOCK, 2, ATTN_HEADS, ATTN_HEAD_DIM), 1, 0)
    kpos = jnp.arange(S)
    slopes = _alibi_slopes()
    scale = ATTN_HEAD_DIM ** -0.5

    def block(args):
        qblk, i = args
        qpos = i * Q_BLOCK + jnp.arange(Q_BLOCK)
        dist = jnp.abs(qpos[:, None] - kpos[None, :]).astype(jnp.float32)
        bias = -slopes[:, None, None] * dist
        s = jnp.einsum('bqnhd,bknhd->bnhqk', qblk, k).astype(jnp.float32) * scale + bias
        p = jax.nn.softmax(s, axis=-1)
        a = p[:, 0] - lam * p[:, 1]
        return jnp.einsum('bhqk,bkhe->bqhe', a.astype(v.dtype), v)

    out = lax.map(block, (qb, jnp.arange(nb)))
    return jnp.moveaxis(out, 0, 1).reshape(B, S, ATTN_HEADS, 2 * ATTN_HEAD_DIM)


def _spatial_gating(u, vg, ln_g, ln_b, w_s, b_s):
    u = jax.nn.gelu(u, approximate=False)
    vg = _layernorm(jax.nn.gelu(vg, approximate=False), ln_g, ln_b)
    B, S, W = vg.shape
    vc = vg.reshape(B, S // GMLP_CHUNK, GMLP_CHUNK, GMLP_GROUPS, GMLP_GROUP_DIM)
    mixed = jnp.einsum('gts,bcsgk->bctgk', w_s, vc) + jnp.swapaxes(b_s, 0, 1)[None, None, :, :, None]
    return u * mixed.reshape(B, S, W)


def _mixer(h, w_in, lq1, lk1, lq2, lk2, g_subln, ln_v_g, ln_v_b, w_s, b_s, w_a, w_b, w_o, lam_init):
    B, S, _ = h.shape
    z = h @ w_in
    cuts = np.cumsum([ATTN_QK_WIDTH, ATTN_QK_WIDTH, ATTN_V_WIDTH, GMLP_WIDTH, GMLP_WIDTH, D_MODEL]).tolist()
    q, k, v, u, vg, ga, gb = jnp.split(z, cuts, axis=-1)
    q = q.reshape(B, S, 2, ATTN_HEADS, ATTN_HEAD_DIM)
    k = k.reshape(B, S, 2, ATTN_HEADS, ATTN_HEAD_DIM)
    v = v.reshape(B, S, ATTN_HEADS, 2 * ATTN_HEAD_DIM)
    lam = _diff_lambda(lq1, lk1, lq2, lk2, lam_init)
    o = _diff_attention(q, k, v, lam)
    o = _rmsnorm(o, g_subln) * (1.0 - lam_init)
    ya = o.reshape(B, S, ATTN_V_WIDTH) @ w_a
    yb = _spatial_gating(u, vg, ln_v_g, ln_v_b, w_s, b_s) @ w_b
    merged = jax.nn.sigmoid(ga) * ya + jax.nn.sigmoid(gb) * yb
    return merged @ w_o


def _expert_choice_moe(h, w_r, b_r, w_g, w_u, w_d):
    B, S, _ = h.shape
    cap = EC_CAPACITY * S // N_EXPERTS
    logits = (h @ w_r + b_r).astype(jnp.float32)
    aff = jax.nn.softmax(logits, axis=-1)
    gate, idx = lax.top_k(jnp.swapaxes(aff, 1, 2), cap)
    bidx = jnp.arange(B)[:, None, None]
    xg = h[bidx, idx]
    hid = jax.nn.silu(jnp.einsum('becd,edf->becf', xg, w_g)) * jnp.einsum('becd,edf->becf', xg, w_u)
    y = jnp.einsum('becf,efd->becd', hid, w_d) * gate[..., None].astype(h.dtype)
    return jnp.zeros_like(h).at[bidx, idx].add(y)


def _modulate(x, g, shift, scale):
    return _rmsnorm(x, g) * (1.0 + scale[:, None, :]) + shift[:, None, :]


def setup_inputs(seed: int = 0) -> dict:
    key = jax.random.key(seed)
    ks = jax.random.split(key, 26)
    L = DEPTH

    def nrm(k, shape, s):
        return jax.random.normal(k, shape, jnp.float32) * s

    return {
        'x': nrm(ks[0], (BATCH, SEQ, D_MODEL), 1.0),
        'c': nrm(ks[1], (BATCH, D_MODEL), 1.0),
        'w_ada': nrm(ks[2], (L, D_MODEL, 6 * D_MODEL), 0.25 * D_MODEL ** -0.5),
        'b_ada': nrm(ks[3], (L, 6 * D_MODEL), 0.01),
        'g_pre_mix': 1.0 + nrm(ks[4], (L, D_MODEL), 0.05),
        'g_post_mix': 1.0 + nrm(ks[5], (L, D_MODEL), 0.05),
        'w_in': nrm(ks[6], (L, D_MODEL, IN_WIDTH), D_MODEL ** -0.5),
        'lam_q1': nrm(ks[7], (L, ATTN_HEAD_DIM), 0.1),
        'lam_k1': nrm(ks[8], (L, ATTN_HEAD_DIM), 0.1),
        'lam_q2': nrm(ks[9], (L, ATTN_HEAD_DIM), 0.1),
        'lam_k2': nrm(ks[10], (L, ATTN_HEAD_DIM), 0.1),
        'g_subln': 1.0 + nrm(ks[11], (L, 2 * ATTN_HEAD_DIM), 0.05),
        'ln_v_g': 1.0 + nrm(ks[12], (L, GMLP_WIDTH), 0.05),
        'ln_v_b': nrm(ks[13], (L, GMLP_WIDTH), 0.01),
        'w_spatial': nrm(ks[14], (L, GMLP_GROUPS, GMLP_CHUNK, GMLP_CHUNK), GMLP_CHUNK ** -0.5),
        'b_spatial': 1.0 + nrm(ks[15], (L, GMLP_GROUPS, GMLP_CHUNK), 0.01),
        'w_branch_a': nrm(ks[16], (L, ATTN_V_WIDTH, D_MODEL), ATTN_V_WIDTH ** -0.5),
        'w_branch_b': nrm(ks[17], (L, GMLP_WIDTH, D_MODEL), GMLP_WIDTH ** -0.5),
        'w_out': nrm(ks[18], (L, D_MODEL, D_MODEL), D_MODEL ** -0.5),
        'g_pre_ffn': 1.0 + nrm(ks[19], (L, D_MODEL), 0.05),
        'g_post_ffn': 1.0 + nrm(ks[20], (L, D_MODEL), 0.05),
        'w_router': nrm(ks[21], (L, D_MODEL, N_EXPERTS), D_MODEL ** -0.5),
        'b_router': nrm(ks[22], (L, N_EXPERTS), 0.01),
        'w_gate_e': nrm(ks[23], (L, N_EXPERTS, D_MODEL, EXPERT_FF), D_MODEL ** -0.5),
        'w_up_e': nrm(ks[24], (L, N_EXPERTS, D_MODEL, EXPERT_FF), D_MODEL ** -0.5),
        'w_down_e': nrm(ks[25], (L, N_EXPERTS, EXPERT_FF, D_MODEL), EXPERT_FF ** -0.5),
    }


def reference(x, c, w_ada, b_ada, g_pre_mix, g_post_mix, w_in, lam_q1, lam_k1, lam_q2, lam_k2,
              g_subln, ln_v_g, ln_v_b, w_spatial, b_spatial, w_branch_a, w_branch_b, w_out,
              g_pre_ffn, g_post_ffn, w_router, b_router, w_gate_e, w_up_e, w_down_e):
    c_act = jax.nn.silu(c)
    for l in range(DEPTH):
        lam_init = 0.8 - 0.6 * math.exp(-0.3 * l)
        mod = c_act @ w_ada[l] + b_ada[l]
        sh1, sc1, gt1, sh2, sc2, gt2 = jnp.split(mod, 6, axis=-1)
        h = _modulate(x, g_pre_mix[l], sh1, sc1)
        y = _mixer(h, w_in[l], lam_q1[l], lam_k1[l], lam_q2[l], lam_k2[l], g_subln[l],
                   ln_v_g[l], ln_v_b[l], w_spatial[l], b_spatial[l],
                   w_branch_a[l], w_branch_b[l], w_out[l], lam_init)
        x = x + gt1[:, None, :] * _rmsnorm(y, g_post_mix[l])
        h = _modulate(x, g_pre_ffn[l], sh2, sc2)
        y = _expert_choice_moe(h, w_router[l], b_router[l], w_gate_e[l], w_up_e[l], w_down_e[l])
        x = x + gt2[:, None, :] * _rmsnorm(y, g_post_ffn[l])
    return x
```

```cpp
#include <hip/hip_runtime.h>
#include <hip/hip_bf16.h>
#include <cstdio>
#include <cstdint>
namespace pg8 {
#define PG8_LAS __attribute__((address_space(3)))
typedef unsigned short bf16_t;
typedef short bf16x8 __attribute__((ext_vector_type(8)));
typedef float f32x4 __attribute__((ext_vector_type(4)));
typedef unsigned u32x4 __attribute__((ext_vector_type(4)));
constexpr int BM = 256, BK = 64, HALF = 128, HTB = HALF * BK * 2  , STAGE_BYTES = 8 * HTB, NXCD = 8, WGM = 8;

__host__ __device__ __forceinline__ int lds_byte(int r, int c) { const int st = (r >> 4) * 2 + (c >> 5), rr = r & 15, cc = c & 31, ob = rr * 64 + cc * 2; return st * 1024 + (ob ^ (((ob >> 9) & 1) << 5)); }
__host__ __device__ __forceinline__ void stage_rc(int b, int& R, int& C) { const int st = b / 1024, sb = b % 1024, swz = sb ^ (((sb >> 9) & 1) << 5); R = (st >> 1) * 16 + swz / 64; C = (st & 1) * 32 + (swz % 64) / 2; }
__host__ __device__ __forceinline__ int perm32(int rho) { const int n = rho >> 4, i = rho & 15; return 8 * (i >> 2) + 4 * n + (i & 3); }

struct Unit { int pm, pn; };
struct Gemm { const bf16_t* A; const bf16_t* Bt; int M, N, K; };

struct StaticOrder {
    int nM, nN, nwg, G, c;
    __host__ __device__ void init(int M, int N, int G_, int c_) { nM = M / BM; nN = N / BM; nwg = nM * nN; G = G_; c = c_; }
    __host__ __device__ bool next(int i, Unit& u) const {
        const long L = (long)i * G + c; if (L >= nwg) return false;
        int wgid = (int)L; { const int q = nwg / NXCD, r = nwg % NXCD, xcd = wgid % NXCD, off = wgid / NXCD; wgid = (xcd < r ? xcd * (q + 1) : r * (q + 1) + (xcd - r) * q) + off; }
        const int nig = WGM * nN, gid = wgid / nig, fm = gid * WGM, gsz = (nM - fm) < WGM ? (nM - fm) : WGM;
        u.pm = fm + ((wgid % nig) % gsz); u.pn = (wgid % nig) / gsz; return true;
    }
    __device__ __forceinline__ void a_ready(const Unit&) const {}
    __device__ __forceinline__ void done(const Unit&) const {}
};

typedef float f32x2c_t __attribute__((ext_vector_type(2))); typedef __bf16 bf16x2c_t __attribute__((ext_vector_type(2)));
__device__ __forceinline__ unsigned cvt_pk_bf16(float lo, float hi) { f32x2c_t v = {lo, hi}; bf16x2c_t b = __builtin_convertvector(v, bf16x2c_t); return __builtin_bit_cast(unsigned, b); }
typedef float f32x2 __attribute__((ext_vector_type(2)));
__device__ __forceinline__ f32x2 gelu_pk(f32x2 v) {
    const f32x2 av = __builtin_elementwise_abs(v), d = av * 0.2316418882f + 1.0f;
    f32x2 t; t.x = __builtin_amdgcn_rcpf(d.x); t.y = __builtin_amdgcn_rcpf(d.y);
    f32x2 q = t * 0.5307027145f + (-0.7265760135f); q = q * t + 0.7107068705f; q = q * t + (-0.142248368f); q = q * t + 0.127414796f; q = q * t;
    const f32x2 s = (v * v) * (-0.72134752044f);
    f32x2 e; e.x = __builtin_amdgcn_exp2f(s.x); e.y = __builtin_amdgcn_exp2f(s.y);
    const f32x2 m = v * (q * e), r = v - m;
    f32x2 o; o.x = v.x < 0.f ? m.x : r.x; o.y = v.y < 0.f ? m.y : r.y; return o;
}

template <class Epi, class Sched, bool ALIGN_EPI = false, bool SP2 = false>
__device__ __forceinline__ void gemm_phase(PG8_LAS unsigned char* lds, const Gemm g, const Sched& S, const Epi& E) {
    int tid_ = threadIdx.x; asm volatile("" : "+v"(tid_));
    const int tid = tid_, wid = __builtin_amdgcn_readfirstlane(tid >> 6), lane = tid & 63, wr = wid >> 2, wc = wid & 3, fr = lane & 15, fq = lane >> 4;
    const int K = g.K, nt = K / BK;
    unsigned voffA[2], voffB[2];
#pragma unroll
    for (int i = 0; i < 2; ++i) { int R, C; stage_rc(tid * 16 + i * 8192, R, C); const int Rb = Epi::PERM ? ((R & ~31) + perm32(R & 31)) : R;
        voffA[i] = (unsigned)(R * K + C) * 2u; voffB[i] = (unsigned)(Rb * K + C) * 2u; }
    const size_t kstep = (size_t)(BK * 2);
    const size_t hstep = (size_t)HALF * K * 2;
    const size_t tstep = 2 * hstep;
    const unsigned ldsw = (unsigned)wid * 1024u;
    const int aoff = lds_byte(wr * 64 + fr, fq * 8), boff = lds_byte(wc * 32 + fr, fq * 8);
#define PG8_SA(b, h) (((b) * 2 + (h)) * HTB)
#define PG8_SB(b, h) ((4 + (b) * 2 + (h)) * HTB)
#define PG8_STAGE(bufoff, gbase, voff) do { _Pragma("unroll") for (int _i = 0; _i < 2; ++_i) \
        __builtin_amdgcn_global_load_lds((const unsigned*)((const char*)(gbase) + (voff)[_i]), (PG8_LAS unsigned*)(lds + (bufoff) + ldsw + _i * 8192), 16, 0, 0); } while (0)
#define PG8_LDA(dst, b, h) do { _Pragma("unroll") for (int m = 0; m < 4; ++m) _Pragma("unroll") for (int k = 0; k < 2; ++k) dst[m][k] = *(const PG8_LAS bf16x8*)(lds + PG8_SA(b, h) + aoff + m * 2048 + k * 1024); } while (0)
#define PG8_LDB(dst, b, h) do { _Pragma("unroll") for (int n = 0; n < 2; ++n) _Pragma("unroll") for (int k = 0; k < 2; ++k) dst[n][k] = *(const PG8_LAS bf16x8*)(lds + PG8_SB(b, h) + boff + n * 2048 + k * 1024); } while (0)
#define PG8_MMA(ai, bj, At, Bt) do { __builtin_amdgcn_s_setprio(1); _Pragma("unroll") for (int m = 0; m < 4; ++m) _Pragma("unroll") for (int n = 0; n < 2; ++n) _Pragma("unroll") for (int k = 0; k < 2; ++k) \
        acc[ai][bj][m][n] = __builtin_amdgcn_mfma_f32_16x16x32_bf16(Bt[n][k], At[m][k], acc[ai][bj][m][n], 0, 0, 0); __builtin_amdgcn_s_setprio(0); } while (0)
#define PG8_WAIT_V(n) asm volatile("s_waitcnt vmcnt(" #n ")" ::: "memory")
#define PG8_WAIT_L(n) asm volatile("s_waitcnt lgkmcnt(" #n ")" ::: "memory")
#define PG8_BAR __builtin_amdgcn_s_barrier()
#define PG8_SCHED __builtin_amdgcn_sched_barrier(0)
    Unit cur, nxt; int ui = 0;
    if (!S.next(0, cur)) return;
    f32x4 acc[2][2][4][2];
#pragma unroll
    for (int a = 0; a < 2; ++a)
#pragma unroll
        for (int b = 0; b < 2; ++b)
#pragma unroll
            for (int m = 0; m < 4; ++m)
#pragma unroll
                for (int n = 0; n < 2; ++n) acc[a][b][m][n] = (f32x4){0.f, 0.f, 0.f, 0.f};
    bf16x8 At[4][2], B0[2][2], B1[2][2];
    const char* cA = (const char*)g.A + (size_t)cur.pm * tstep; const char* cB = (const char*)g.Bt + (size_t)cur.pn * tstep;
    S.a_ready(cur);
    if constexpr (SP2) {
        PG8_STAGE(PG8_SB(0, 0), cB, voffB); PG8_STAGE(PG8_SB(0, 1), cB + hstep, voffB); PG8_STAGE(PG8_SA(0, 0), cA, voffA); PG8_STAGE(PG8_SA(0, 1), cA + hstep, voffA);
        if (wr == 1) PG8_BAR;
        PG8_WAIT_V(2); PG8_BAR;
        PG8_STAGE(PG8_SB(1, 0), cB + kstep, voffB); PG8_STAGE(PG8_SA(1, 0), cA + kstep, voffA); PG8_STAGE(PG8_SB(1, 1), cB + hstep + kstep, voffB);
        PG8_WAIT_V(6); PG8_BAR;
    } else {
        PG8_STAGE(PG8_SB(0, 0), cB, voffB); PG8_STAGE(PG8_SA(0, 0), cA, voffA); PG8_STAGE(PG8_SB(0, 1), cB + hstep, voffB); PG8_STAGE(PG8_SA(0, 1), cA + hstep, voffA);
        if (wr == 1) PG8_BAR;
        PG8_WAIT_V(4); PG8_BAR;
        PG8_STAGE(PG8_SB(1, 0), cB + kstep, voffB); PG8_STAGE(PG8_SA(1, 0), cA + kstep, voffA); PG8_STAGE(PG8_SB(1, 1), cB + hstep + kstep, voffB);
        PG8_WAIT_V(6); PG8_BAR;
    }
    for (;;) {
        const bool has_next = S.next(ui + 1, nxt);
        const char* nA = has_next ? (const char*)g.A + (size_t)nxt.pm * tstep : cA; const char* nB = has_next ? (const char*)g.Bt + (size_t)nxt.pn * tstep : cB;
        for (int t = 0; t < nt; t += 2) {
            const bool last = (t == nt - 2);
            const char* a1 = cA + (size_t)(t + 1) * kstep;
            const char* a2 = last ? nA : cA + (size_t)(t + 2) * kstep; const char* b2 = last ? nB : cB + (size_t)(t + 2) * kstep;
            const char* a3 = a2 + kstep; const char* b3 = b2 + kstep;
            if (last && has_next) S.a_ready(nxt);
            if constexpr (SP2) {
            PG8_LDB(B0, 0, 0); PG8_LDB(B1, 0, 1); PG8_SCHED; PG8_LDA(At, 0, 0); PG8_STAGE(PG8_SA(1, 1), a1 + hstep, voffA);
            PG8_WAIT_V(8); PG8_WAIT_L(0); PG8_BAR; PG8_MMA(0, 0, At, B0); PG8_MMA(0, 1, At, B1); PG8_BAR; PG8_SCHED;
            PG8_LDA(At, 0, 1); PG8_STAGE(PG8_SB(0, 0), b2, voffB); PG8_STAGE(PG8_SB(0, 1), b2 + hstep, voffB); PG8_STAGE(PG8_SA(0, 0), a2, voffA);
            PG8_WAIT_V(8); PG8_WAIT_L(0); PG8_BAR; PG8_MMA(1, 0, At, B0); PG8_MMA(1, 1, At, B1); PG8_BAR; PG8_SCHED;
            PG8_LDB(B0, 1, 0); PG8_LDB(B1, 1, 1); PG8_SCHED; PG8_LDA(At, 1, 0); PG8_STAGE(PG8_SA(0, 1), a2 + hstep, voffA);
            PG8_WAIT_V(8); PG8_WAIT_L(0); PG8_BAR; PG8_MMA(0, 0, At, B0); PG8_MMA(0, 1, At, B1); PG8_BAR; PG8_SCHED;
            PG8_LDA(At, 1, 1); PG8_STAGE(PG8_SB(1, 0), b3, voffB); PG8_STAGE(PG8_SB(1, 1), b3 + hstep, voffB); PG8_STAGE(PG8_SA(1, 0), a3, voffA);
            PG8_WAIT_V(8); PG8_WAIT_L(0); PG8_BAR; PG8_MMA(1, 0, At, B0); PG8_MMA(1, 1, At, B1); PG8_BAR; PG8_SCHED;
            } else {
            PG8_LDB(B0, 0, 0); PG8_SCHED; PG8_LDA(At, 0, 0); PG8_STAGE(PG8_SA(1, 1), a1 + hstep, voffA);
            PG8_WAIT_L(8); PG8_BAR; PG8_WAIT_L(0); PG8_MMA(0, 0, At, B0); PG8_BAR; PG8_SCHED;
            PG8_LDB(B1, 0, 1); PG8_STAGE(PG8_SB(0, 0), b2, voffB);
            PG8_BAR; PG8_WAIT_L(0); PG8_MMA(0, 1, At, B1); PG8_BAR;
            PG8_LDA(At, 0, 1); PG8_STAGE(PG8_SA(0, 0), a2, voffA);
            PG8_BAR; PG8_WAIT_L(0); PG8_MMA(1, 0, At, B0); PG8_BAR; PG8_SCHED;
            PG8_STAGE(PG8_SB(0, 1), b2 + hstep, voffB);
            PG8_WAIT_V(6); PG8_BAR; PG8_MMA(1, 1, At, B1); PG8_BAR;
            PG8_LDB(B0, 1, 0); PG8_SCHED; PG8_LDA(At, 1, 0); PG8_STAGE(PG8_SA(0, 1), a2 + hstep, voffA);
            PG8_WAIT_L(8); PG8_BAR; PG8_WAIT_L(0); PG8_MMA(0, 0, At, B0); PG8_BAR; PG8_SCHED;
            PG8_LDB(B1, 1, 1); PG8_STAGE(PG8_SB(1, 0), b3, voffB);
            PG8_BAR; PG8_WAIT_L(0); PG8_MMA(0, 1, At, B1); PG8_BAR;
            PG8_LDA(At, 1, 1); PG8_STAGE(PG8_SA(1, 0), a3, voffA);
            PG8_BAR; PG8_WAIT_L(0); PG8_MMA(1, 0, At, B0); PG8_BAR; PG8_SCHED;
            PG8_STAGE(PG8_SB(1, 1), b3 + hstep, voffB);
            PG8_WAIT_V(6); PG8_BAR; PG8_MMA(1, 1, At, B1); PG8_BAR;
            }
        }
        if constexpr (ALIGN_EPI) { if (wr == 0) PG8_BAR; }
        if constexpr (!Epi::AFTER_DRAIN) { E(acc, cur, wr, wc, fr, fq); S.done(cur); }
        if (!has_next) break;
#pragma unroll
        for (int a = 0; a < 2; ++a)
#pragma unroll
            for (int b = 0; b < 2; ++b)
#pragma unroll
                for (int m = 0; m < 4; ++m)
#pragma unroll
                    for (int n = 0; n < 2; ++n) acc[a][b][m][n] = (f32x4){0.f, 0.f, 0.f, 0.f};
        cur = nxt; cA = nA; cB = nB; ++ui;
        if constexpr (ALIGN_EPI) { if (wr == 1) PG8_BAR; }
    }
    PG8_WAIT_V(0);
    if constexpr (!ALIGN_EPI) { if (wr == 0) PG8_BAR; }
    PG8_BAR;
    if constexpr (Epi::AFTER_DRAIN) { E.fused(acc, cur, wr, wc, fr, fq, lds, wid, lane); S.done(cur); }
#undef PG8_SA
#undef PG8_SB
#undef PG8_STAGE
#undef PG8_LDA
#undef PG8_LDB
#undef PG8_MMA
#undef PG8_WAIT_V
#undef PG8_WAIT_L
#undef PG8_BAR
#undef PG8_SCHED
}
}
#define GAS __attribute__((address_space(1)))
#define LAS __attribute__((address_space(3)))
typedef unsigned short bf16;
typedef unsigned v4u __attribute__((ext_vector_type(4)));
typedef float f32x4 __attribute__((ext_vector_type(4)));
typedef short bf16x8 __attribute__((ext_vector_type(8)));
typedef GAS unsigned gu32;
typedef GAS unsigned long long gu64;
#define RLX_AGENT __ATOMIC_RELAXED, __HIP_MEMORY_SCOPE_AGENT
#define LDS_WAIT() asm volatile("s_waitcnt lgkmcnt(0)" ::: "memory")
#define VM_WAIT() asm volatile("s_waitcnt vmcnt(0)" ::: "memory")
__device__ __forceinline__ unsigned long long rt() { return __builtin_amdgcn_s_memrealtime(); }
__device__ __forceinline__ unsigned f2bf(float f) { unsigned u = __builtin_bit_cast(unsigned, f); return (u + 0x7fffu + ((u >> 16) & 1u)) >> 16; }
__device__ __forceinline__ unsigned pk2(float lo, float hi) { return f2bf(lo) | (f2bf(hi) << 16); }
#define XB_TMO      128
#define XB_XCNT(j)  (256  + 64 * (j))
#define XB_XSUB(j)  (1280 + 64 * (j))
#define XB_XGEN(j)  (2304 + 64 * (j))
#define XB_TOP      3328
#define XB_TOPGEN   3392
#define XCD_BAR_WORDS 3456
#define XB_SPIN_CAP (1u << 18)

__device__ __forceinline__ unsigned xb_ld(unsigned* p)              { return __hip_atomic_load(p, __ATOMIC_RELAXED, __HIP_MEMORY_SCOPE_AGENT); }
__device__ __forceinline__ unsigned xb_add(unsigned* p, unsigned v) { return __hip_atomic_fetch_add(p, v, __ATOMIC_RELAXED, __HIP_MEMORY_SCOPE_AGENT); }
__device__ __forceinline__ unsigned xb_xcc_id() { return (unsigned)__builtin_amdgcn_s_getreg((3 << 11) | 20) & 0xFu; }
#define XB_SPIN(cond, bar) do { unsigned _sp = 0; while (cond) { __builtin_amdgcn_s_sleep(1); \
    if ((++_sp & 255u) == 0u) { if (xb_ld(&(bar)[XB_TMO])) break; if (_sp > XB_SPIN_CAP) { atomicAdd(&(bar)[XB_TMO], 1u); break; } } } } while (0)

struct XcdBarrier {
    unsigned* bar; unsigned x;
    volatile LAS unsigned* st;
};

__device__ __forceinline__ XcdBarrier xcd_barrier_post(unsigned* bar, volatile LAS unsigned* st) {
    XcdBarrier b; b.bar = bar; b.x = xb_xcc_id(); b.st = st;
    if (threadIdx.x == 0) (void)xb_add(&bar[XB_XCNT(b.x)], 1u);
    return b;
}
__device__ __forceinline__ void xcd_barrier_complete(unsigned* bar, unsigned x, unsigned& nloc, unsigned& nx) {
    const unsigned G = gridDim.x * gridDim.y * gridDim.z;
    unsigned sum, cnt, mine, sp = 0u;
    for (;;) {
        sum = 0u; cnt = 0u; mine = 0u;
#pragma unroll
        for (unsigned j = 0; j < 16; ++j) { const unsigned c = xb_ld(&bar[XB_XCNT(j)]); sum += c; cnt += (c > 0u) ? 1u : 0u; mine = (j == x) ? c : mine; }
        if (sum == G) break;
        __builtin_amdgcn_s_sleep(1);
        if ((++sp & 255u) == 0u) { if (xb_ld(&bar[XB_TMO])) break; if (sp > XB_SPIN_CAP) { atomicAdd(&bar[XB_TMO], 1u); break; } }
    }
    nloc = mine > 0u ? mine : 1u; nx = cnt > 0u ? cnt : 1u;
}

__device__ __forceinline__ void xcd_barrier(const XcdBarrier& b) {
    asm volatile("s_waitcnt vmcnt(0)" ::: "memory");
    __syncthreads();
    if (threadIdx.x == 0) {
        unsigned* bar = b.bar;
        __builtin_amdgcn_s_waitcnt(0);
        unsigned nloc = b.st[0], nx = b.st[1];
        if (nloc == 0u) { xcd_barrier_complete(bar, b.x, nloc, nx); b.st[0] = nloc; b.st[1] = nx; }
        const unsigned old = xb_add(&bar[XB_XSUB(b.x)], 1u);
        const unsigned gen = old / nloc;
        if (old + 1u == (gen + 1u) * nloc) {
            __builtin_amdgcn_fence(__ATOMIC_RELEASE, "agent");
            asm volatile("s_waitcnt vmcnt(0)" ::: "memory");
            const unsigned og = xb_add(&bar[XB_TOP], 1u);
            const unsigned tg = og / nx;
            if (og + 1u == (tg + 1u) * nx) xb_add(&bar[XB_TOPGEN], 1u);
            else XB_SPIN(xb_ld(&bar[XB_TOPGEN]) == tg, bar);
            __builtin_amdgcn_fence(__ATOMIC_ACQUIRE, "agent");
            xb_add(&bar[XB_XGEN(b.x)], 1u);
            asm volatile("s_waitcnt vmcnt(0)" ::: "memory");
        } else {
            XB_SPIN(xb_ld(&bar[XB_XGEN(b.x)]) == gen, bar);
            __builtin_amdgcn_fence(__ATOMIC_ACQUIRE, "agent");
            asm volatile("s_waitcnt vmcnt(0)" ::: "memory");
        }
    }
    __syncthreads();
}

constexpr int BATCH = 2, SEQ = 8192, D = 1024, DEPTH = 4, M = BATCH * SEQ;
constexpr int NHEAD = 8, NIN = 7168, NE = 16, FF = 2048, CAP = 1024, NSEL = BATCH * NE * CAP;
constexpr float NORM_EPS = 1e-6f;
constexpr float C2 = 0.125f * 1.4426950408889634f;

namespace pg8 {
__device__ __forceinline__ float bf_lo(unsigned w) { return __builtin_bit_cast(float, w << 16); }
__device__ __forceinline__ float bf_hi(unsigned w) { return __builtin_bit_cast(float, w & 0xffff0000u); }
__device__ __forceinline__ float sigmoidf_(float x) { return __builtin_amdgcn_rcpf(1.0f + __builtin_amdgcn_exp2f(-1.4426950408889634f * x)); }

struct EpiIn {
    static constexpr bool PERM = true, AFTER_DRAIN = false;
    bf16_t* O;
    template <int ACT> __device__ __forceinline__ void tile(const f32x4 (&acc)[2][2][4][2], bf16_t* base, int row0, int col0, float sc) const {
#pragma unroll
        for (int ai = 0; ai < 2; ++ai)
#pragma unroll
            for (int m = 0; m < 4; ++m) { bf16_t* rowp = base + (size_t)(row0 + ai * HALF + m * 16) * 1024 + col0;
#pragma unroll
                for (int bj = 0; bj < 2; ++bj) { f32x4 v0 = acc[ai][bj][m][0], v1 = acc[ai][bj][m][1];
                    if (ACT == 1) { f32x2 a = gelu_pk((f32x2){v0[0], v0[1]}), b = gelu_pk((f32x2){v0[2], v0[3]}), c = gelu_pk((f32x2){v1[0], v1[1]}), d = gelu_pk((f32x2){v1[2], v1[3]});
                        v0 = (f32x4){a.x, a.y, b.x, b.y}; v1 = (f32x4){c.x, c.y, d.x, d.y}; }
                    else if (ACT == 2) { v0 = (f32x4){sigmoidf_(v0[0]), sigmoidf_(v0[1]), sigmoidf_(v0[2]), sigmoidf_(v0[3])}; v1 = (f32x4){sigmoidf_(v1[0]), sigmoidf_(v1[1]), sigmoidf_(v1[2]), sigmoidf_(v1[3])}; }
                    else { v0 = v0 * sc; v1 = v1 * sc; }
                    u32x4 w; w.x = cvt_pk_bf16(v0[0], v0[1]); w.y = cvt_pk_bf16(v0[2], v0[3]); w.z = cvt_pk_bf16(v1[0], v1[1]); w.w = cvt_pk_bf16(v1[2], v1[3]);
                    *(u32x4*)(rowp + bj * HALF) = w; } }
    }
    __device__ __forceinline__ void operator()(const f32x4 (&acc)[2][2][4][2], const Unit& u, int wr, int wc, int fr, int fq) const {
        const int region = u.pn >> 2, colt = (u.pn & 3) * BM;
        bf16_t* base = O + (size_t)region * ((size_t)M * 1024);
        const int row0 = u.pm * BM + wr * 64 + fr, col0 = colt + wc * 32 + 8 * fq;
        if (region < 3) tile<0>(acc, base, row0, col0, region == 0 ? C2 : 1.0f);
        else if (region < 5) tile<1>(acc, base, row0, col0, 1.0f);
        else tile<2>(acc, base, row0, col0, 1.0f);
    }
};

template <bool ADD> struct EpiGate {
    static constexpr bool PERM = true, AFTER_DRAIN = false;
    const bf16_t* G; bf16_t* O;
    __device__ __forceinline__ void operator()(const f32x4 (&acc)[2][2][4][2], const Unit& u, int wr, int wc, int fr, int fq) const {
        const int row0 = u.pm * BM + wr * 64 + fr, col0 = u.pn * BM + wc * 32 + 8 * fq;
#pragma unroll
        for (int ai = 0; ai < 2; ++ai)
#pragma unroll
            for (int m = 0; m < 4; ++m) { const size_t off = (size_t)(row0 + ai * HALF + m * 16) * 1024 + col0;
#pragma unroll
                for (int bj = 0; bj < 2; ++bj) { const f32x4 v0 = acc[ai][bj][m][0], v1 = acc[ai][bj][m][1];
                    const u32x4 g = *(const u32x4*)(G + off + bj * HALF);
                    float r0 = v0[0] * bf_lo(g.x), r1 = v0[1] * bf_hi(g.x), r2 = v0[2] * bf_lo(g.y), r3 = v0[3] * bf_hi(g.y);
                    float r4 = v1[0] * bf_lo(g.z), r5 = v1[1] * bf_hi(g.z), r6 = v1[2] * bf_lo(g.w), r7 = v1[3] * bf_hi(g.w);
                    if (ADD) { const u32x4 p = *(const u32x4*)(O + off + bj * HALF);
                        r0 += bf_lo(p.x); r1 += bf_hi(p.x); r2 += bf_lo(p.y); r3 += bf_hi(p.y); r4 += bf_lo(p.z); r5 += bf_hi(p.z); r6 += bf_lo(p.w); r7 += bf_hi(p.w); }
                    u32x4 w; w.x = cvt_pk_bf16(r0, r1); w.y = cvt_pk_bf16(r2, r3); w.z = cvt_pk_bf16(r4, r5); w.w = cvt_pk_bf16(r6, r7);
                    *(u32x4*)(O + off + bj * HALF) = w; } }
    }
};

struct EpiF32 {
    static constexpr bool PERM = false, AFTER_DRAIN = false;
    float* O;
    __device__ __forceinline__ void operator()(const f32x4 (&acc)[2][2][4][2], const Unit& u, int wr, int wc, int fr, int fq) const {
        const int row0 = u.pm * BM + wr * 64 + fr, col0 = u.pn * BM + wc * 32 + 4 * fq;
#pragma unroll
        for (int ai = 0; ai < 2; ++ai)
#pragma unroll
            for (int m = 0; m < 4; ++m) { float* rowp = O + (size_t)(row0 + ai * HALF + m * 16) * 1024 + col0;
#pragma unroll
                for (int bj = 0; bj < 2; ++bj)
#pragma unroll
                    for (int n = 0; n < 2; ++n) *(f32x4*)(rowp + bj * HALF + n * 16) = acc[ai][bj][m][n]; }
    }
};

struct EpiMoe1 {
    static constexpr bool PERM = true, AFTER_DRAIN = false;
    bf16_t* O;
    __device__ __forceinline__ void operator()(const f32x4 (&acc)[2][2][4][2], const Unit& u, int wr, int wc, int fr, int fq) const {
        const int row0 = u.pm * BM + wr * 64 + fr, col0 = (u.pn & 15) * HALF + wc * 32 + 8 * fq;
#pragma unroll
        for (int ai = 0; ai < 2; ++ai)
#pragma unroll
            for (int m = 0; m < 4; ++m) { bf16_t* rowp = O + (size_t)(row0 + ai * HALF + m * 16) * FF + col0;
                float r[8];
#pragma unroll
                for (int n = 0; n < 2; ++n)
#pragma unroll
                    for (int q = 0; q < 4; ++q) { const float g = acc[ai][0][m][n][q], up = acc[ai][1][m][n][q]; r[n * 4 + q] = g * sigmoidf_(g) * up; }
                u32x4 w; w.x = cvt_pk_bf16(r[0], r[1]); w.y = cvt_pk_bf16(r[2], r[3]); w.z = cvt_pk_bf16(r[4], r[5]); w.w = cvt_pk_bf16(r[6], r[7]);
                *(u32x4*)rowp = w; }
    }
};

struct EpiMoe2 {
    static constexpr bool PERM = true, AFTER_DRAIN = false;
    bf16_t* O; const float* gate;
    __device__ __forceinline__ void operator()(const f32x4 (&acc)[2][2][4][2], const Unit& u, int wr, int wc, int fr, int fq) const {
        const int row0 = u.pm * BM + wr * 64 + fr, col0 = (u.pn & 3) * BM + wc * 32 + 8 * fq;
#pragma unroll
        for (int ai = 0; ai < 2; ++ai)
#pragma unroll
            for (int m = 0; m < 4; ++m) { const int row = row0 + ai * HALF + m * 16; const float gt = gate[row]; bf16_t* rowp = O + (size_t)row * 1024 + col0;
#pragma unroll
                for (int bj = 0; bj < 2; ++bj) { const f32x4 v0 = acc[ai][bj][m][0] * gt, v1 = acc[ai][bj][m][1] * gt;
                    u32x4 w; w.x = cvt_pk_bf16(v0[0], v0[1]); w.y = cvt_pk_bf16(v0[2], v0[3]); w.z = cvt_pk_bf16(v1[0], v1[1]); w.w = cvt_pk_bf16(v1[2], v1[3]);
                    *(u32x4*)(rowp + bj * HALF) = w; } }
    }
};

struct MoeOrder1 {
    int vcu, G;
    __device__ __forceinline__ bool next(int i, Unit& u) const {
        if (G == 256) { if (i >= 8) return false; const int e = vcu >> 4, c = vcu & 15; u.pm = e * 8 + 4 * (i & 1) + (c & 3); u.pn = e * 16 + 4 * (i >> 1) + (c >> 2); return true; }
        const int id = i * G + vcu; if (id >= NE * 128) return false; const int e = id >> 7, r = id & 127; u.pm = e * 8 + (r & 7); u.pn = e * 16 + (r >> 3); return true;
    }
    __device__ __forceinline__ void a_ready(const Unit&) const {}
    __device__ __forceinline__ void done(const Unit&) const {}
};
struct MoeOrder2 {
    int vcu, G;
    __device__ __forceinline__ bool next(int i, Unit& u) const {
        if (G == 256) { if (i >= 2) return false; const int e = vcu >> 4, c = vcu & 15; u.pm = e * 8 + 4 * i + (c & 3); u.pn = e * 4 + (c >> 2); return true; }
        const int id = i * G + vcu; if (id >= NE * 32) return false; const int e = id >> 5, r = id & 31; u.pm = e * 8 + (r & 7); u.pn = e * 4 + (r >> 3); return true;
    }
    __device__ __forceinline__ void a_ready(const Unit&) const {}
    __device__ __forceinline__ void done(const Unit&) const {}
};
}

namespace att {
using bf16_t = unsigned short;
using bf16x8 = __attribute__((ext_vector_type(8))) short;
using s16x4  = __attribute__((ext_vector_type(4))) short;
using f32x16 = __attribute__((ext_vector_type(16))) float;
using u32x4  = __attribute__((ext_vector_type(4))) unsigned;
constexpr int SHM_V = 64 * 128 * 2, SHM_K = 64 * 64 * 2, OFF_K = 2 * SHM_V, OFF_WS = OFF_K + 2 * SHM_K, LDS_BYTES = OFF_WS + 8 * 64 * 4;
constexpr float THR2 = 8.0f;
#define ATT_KSWZ(row, colB) ((row) * 128 + ((colB) ^ ((((row) >> 1) & 7) << 4)))
#define ATT_SBAR() __builtin_amdgcn_sched_barrier(0)
__device__ __forceinline__ int crow(int r, int hi) { return (r & 3) + 8 * (r >> 2) + 4 * hi; }
typedef float f32x2a_t __attribute__((ext_vector_type(2))); typedef __bf16 bf16x2a_t __attribute__((ext_vector_type(2)));
__device__ __forceinline__ unsigned cvtpk(float lo, float hi) { f32x2a_t v = {lo, hi}; bf16x2a_t b = __builtin_convertvector(v, bf16x2a_t); return __builtin_bit_cast(unsigned, b); }

__device__ __forceinline__ int v_st(int k, int c) { const int kk = (k & ~0xC) | ((k & 4) << 1) | ((k & 8) >> 1); return ((kk >> 3) * 4 + (c >> 5)) * 512 + ((kk & 7) * 32 + (c & 31)) * 2; }
__device__ __forceinline__ int v_rd_base(int lane) { return ((lane & 3) << 3) | (((lane >> 2) & 3) << 6) | (((lane >> 4) & 1) << 5) | (((lane >> 5) & 1) << 8); }
constexpr int v_rd_off(int d0, int ks, int half) { return d0 * 512 + ks * 4096 + half * 2048; }
template <int OFF> __device__ __forceinline__ s16x4 tr_read(int vb) {
  s16x4 r; asm volatile("ds_read_b64_tr_b16 %0, %1 offset:%2" : "=&v"(r) : "v"(vb), "i"(OFF) : "memory"); return r;
}
template <int D0> __device__ __forceinline__ void pv_one(f32x16& od, int vb, bf16x8 pa0, bf16x8 pa1, bf16x8 pa2, bf16x8 pa3) {
  const s16x4 l0 = tr_read<v_rd_off(D0, 0, 0)>(vb), h0 = tr_read<v_rd_off(D0, 0, 1)>(vb), l1 = tr_read<v_rd_off(D0, 1, 0)>(vb), h1 = tr_read<v_rd_off(D0, 1, 1)>(vb);
  const s16x4 l2 = tr_read<v_rd_off(D0, 2, 0)>(vb), h2 = tr_read<v_rd_off(D0, 2, 1)>(vb), l3 = tr_read<v_rd_off(D0, 3, 0)>(vb), h3 = tr_read<v_rd_off(D0, 3, 1)>(vb);
  asm volatile("s_waitcnt lgkmcnt(0)" ::: "memory"); ATT_SBAR();
#define ATT_PK(L, H) (bf16x8){L[0], L[1], L[2], L[3], H[0], H[1], H[2], H[3]}
  od = __builtin_amdgcn_mfma_f32_32x32x16_bf16(pa0, ATT_PK(l0, h0), od, 0, 0, 0);
  od = __builtin_amdgcn_mfma_f32_32x32x16_bf16(pa1, ATT_PK(l1, h1), od, 0, 0, 0);
  od = __builtin_amdgcn_mfma_f32_32x32x16_bf16(pa2, ATT_PK(l2, h2), od, 0, 0, 0);
  od = __builtin_amdgcn_mfma_f32_32x32x16_bf16(pa3, ATT_PK(l3, h3), od, 0, 0, 0);
#undef ATT_PK
}
__device__ __forceinline__ void pv_d0(f32x16* o, int vb, bf16x8 pa0, bf16x8 pa1, bf16x8 pa2, bf16x8 pa3) {
  pv_one<0>(o[0], vb, pa0, pa1, pa2, pa3); pv_one<1>(o[1], vb, pa0, pa1, pa2, pa3); pv_one<2>(o[2], vb, pa0, pa1, pa2, pa3); pv_one<3>(o[3], vb, pa0, pa1, pa2, pa3);
}

__device__ __forceinline__ void qkt(f32x16& p0, f32x16& p1, const char* Ks, const bf16x8* qr, int r32, int hi, float dq, float nsl2, float negm) {
#pragma unroll
  for (int r = 0; r < 16; ++r) { const float t0 = dq + (float)((r & 3) + 8 * (r >> 2)); p0[r] = __builtin_fmaf(nsl2, __builtin_fabsf(t0), negm); p1[r] = __builtin_fmaf(nsl2, __builtin_fabsf(t0 + 32.0f), negm); }
#pragma unroll
  for (int d0 = 0; d0 < 4; ++d0) { const int cb = d0 * 32 + hi * 16;
    const bf16x8 b0 = *reinterpret_cast<const bf16x8*>(Ks + ATT_KSWZ(r32, cb));
    const bf16x8 b1 = *reinterpret_cast<const bf16x8*>(Ks + ATT_KSWZ(32 + r32, cb));
    p0 = __builtin_amdgcn_mfma_f32_32x32x16_bf16(b0, qr[d0], p0, 0, 0, 0);
    p1 = __builtin_amdgcn_mfma_f32_32x32x16_bf16(b1, qr[d0], p1, 0, 0, 0); }
}
template <bool FIRST> __device__ __forceinline__ void partialSM(f32x16& p0, f32x16& p1, float& m_ref, float& alpha) {
  float pmax = p0[0];
#pragma unroll
  for (int r = 1; r < 16; ++r) pmax = fmaxf(pmax, p0[r]);
#pragma unroll
  for (int r = 0; r < 16; ++r) pmax = fmaxf(pmax, p1[r]);
  { auto rr = __builtin_amdgcn_permlane32_swap(__float_as_uint(pmax), __float_as_uint(pmax), false, false);
    pmax = fmaxf(__uint_as_float(rr[0]), __uint_as_float(rr[1])); }
  alpha = 1.f;
  if (FIRST || !__all(pmax <= THR2)) {
    const float dl = FIRST ? pmax : fmaxf(pmax, 0.f);
    if (!FIRST) alpha = __builtin_amdgcn_exp2f(-dl);
    m_ref += dl;
#pragma unroll
    for (int r = 0; r < 16; ++r) { p0[r] -= dl; p1[r] -= dl; }
  }
#pragma unroll
  for (int r = 0; r < 16; ++r) p0[r] = __builtin_amdgcn_exp2f(p0[r]);
}
__device__ __forceinline__ void finishSM(f32x16& p0, f32x16& p1, float alpha, float& l_reg, bf16x8& pa0, bf16x8& pa1, bf16x8& pa2, bf16x8& pa3) {
#pragma unroll
  for (int r = 0; r < 16; ++r) p1[r] = __builtin_amdgcn_exp2f(p1[r]);
  float ps = 0;
#pragma unroll
  for (int r = 0; r < 16; ++r) ps += p0[r];
#pragma unroll
  for (int r = 0; r < 16; ++r) ps += p1[r];
  { auto rr = __builtin_amdgcn_permlane32_swap(__float_as_uint(ps), __float_as_uint(ps), false, false);
    ps = __uint_as_float(rr[0]) + __uint_as_float(rr[1]); }
  l_reg = l_reg * alpha + ps;
#define ATT_PK4(P, BASE, OUT) do { unsigned a0 = cvtpk(P[BASE + 0], P[BASE + 1]), a1 = cvtpk(P[BASE + 2], P[BASE + 3]);   \
    unsigned b0 = cvtpk(P[BASE + 4], P[BASE + 5]), b1 = cvtpk(P[BASE + 6], P[BASE + 7]);                              \
    auto r0 = __builtin_amdgcn_permlane32_swap(a0, b0, false, false); auto r1 = __builtin_amdgcn_permlane32_swap(a1, b1, false, false); \
    u32x4 w = {r0[0], r1[0], r0[1], r1[1]}; OUT = *reinterpret_cast<bf16x8*>(&w); } while (0)
  ATT_PK4(p0, 0, pa0); ATT_PK4(p0, 8, pa1); ATT_PK4(p1, 0, pa2); ATT_PK4(p1, 8, pa3);
#undef ATT_PK4
}

__device__ __forceinline__ void attn_unit(int b, int h, int qb, const bf16_t* __restrict__ QB, const bf16_t* __restrict__ KB, const bf16_t* __restrict__ VB,
                                          bf16_t* __restrict__ OB, float* __restrict__ O1S, float lam, float onemli, const float* __restrict__ gsub, char* lds) {
  int tid_ = threadIdx.x; asm volatile("" : "+v"(tid_));
  const int tid = tid_, wid = __builtin_amdgcn_readfirstlane(tid >> 6), lane = tid & 63, r32 = lane & 31, hi = lane >> 5;
  char* V_lds = lds; char* K_lds = lds + OFF_K;
  float* ws = (float*)(lds + OFF_WS) + wid * 64; float* li_l = ws; float* al_l = ws + 32;
  const float nsl2 = -__builtin_amdgcn_exp2f(-(float)(h + 1)) * 1.4426950408889634f;
  const int q0 = qb * 256, qp = q0 + wid * 32 + r32;
  const size_t rowbase = (size_t)b * SEQ;
  const bf16_t* Vh = VB + rowbase * 1024 + h * 128;
  const int kr = tid >> 3, kc = (tid & 7) * 8, sr = tid >> 4, sc = (tid & 15) * 8;
  const int kst = ATT_KSWZ(kr, kc * 2), vst0 = v_st(sr, sc), vst1 = v_st(32 + sr, sc);
  const int vb0 = (int)(uintptr_t)V_lds + v_rd_base(lane);
  constexpr int NT = SEQ / 64;
  const float dqb = (float)(4 * hi - qp);
  float* const o1w = O1S + (rowbase + q0 + wid * 32) * 1024 + h * 128;
  bf16_t* const obw = OB + (rowbase + q0 + wid * 32) * 1024 + h * 128;
#pragma nounroll
  for (int n = 0; n < 2; ++n) {
    const bf16_t* Kh = KB + rowbase * 1024 + n * 512 + h * 64;
    const bf16_t* Qw = QB + (rowbase + qp) * 1024 + n * 512 + h * 64 + hi * 8;
    bf16x8 qr[4];
#pragma unroll
    for (int d0 = 0; d0 < 4; ++d0) qr[d0] = *reinterpret_cast<const bf16x8*>(Qw + d0 * 16);
    float m_ref = 0.f, l_reg = 0.f; f32x16 o[4] = {};
    float dqn = dqb; asm volatile("" : "+v"(dqn));
    struct { bf16x8 vs0, vs1, ks; } sr_[2];
#define ATT_SLOAD(i, k0) do { sr_[i].vs0 = *reinterpret_cast<const bf16x8*>(&Vh[(size_t)((k0) + sr) * 1024 + sc]); sr_[i].vs1 = *reinterpret_cast<const bf16x8*>(&Vh[(size_t)((k0) + 32 + sr) * 1024 + sc]); \
    sr_[i].ks = *reinterpret_cast<const bf16x8*>(&Kh[(size_t)((k0) + kr) * 1024 + kc]); } while (0)
#define ATT_SWRITE(bb, i) do { *(bf16x8*)(V_lds + (bb) * SHM_V + vst0) = sr_[i].vs0; *(bf16x8*)(V_lds + (bb) * SHM_V + vst1) = sr_[i].vs1; *(bf16x8*)(K_lds + (bb) * SHM_K + kst) = sr_[i].ks; } while (0)
#define ATT_SWAIT() asm volatile("s_waitcnt vmcnt(3)" ::: "memory")
#define ATT_RESC(a) do { if (__any((a) < 1.f)) { if (hi == 0) al_l[r32] = (a); asm volatile("s_waitcnt lgkmcnt(0)" ::: "memory"); \
    _Pragma("unroll") for (int d = 0; d < 4; ++d) _Pragma("unroll") for (int r = 0; r < 16; ++r) o[d][r] *= al_l[crow(r, hi)]; } } while (0)
    f32x16 pA0, pA1, pB0, pB1; float alA, alB; bf16x8 pa0, pa1, pa2, pa3;
    constexpr int SE = 0, SO = 1;
    ATT_SLOAD(SE, 0); asm volatile("s_waitcnt vmcnt(0)" ::: "memory"); ATT_SWRITE(0, SE); __syncthreads();
    qkt(pA0, pA1, K_lds, qr, r32, hi, dqn, nsl2, 0.f); partialSM<true>(pA0, pA1, m_ref, alA);
    ATT_SLOAD(SO, 64); ATT_SLOAD(SE, 128);
    ATT_SWAIT(); ATT_SWRITE(1, SO); __syncthreads();
#pragma nounroll
    for (int j = 1; j + 1 < NT; j += 2) {
      ATT_SBAR(); qkt(pB0, pB1, K_lds + SHM_K, qr, r32, hi, dqn + (float)(j * 64), nsl2, -m_ref);
      finishSM(pA0, pA1, alA, l_reg, pa0, pa1, pa2, pa3); ATT_SBAR();
      ATT_SLOAD(SO, (j + 2) * 64); ATT_SBAR();
      pv_d0(o, vb0, pa0, pa1, pa2, pa3); partialSM<false>(pB0, pB1, m_ref, alB);
      __syncthreads(); ATT_SWAIT(); ATT_SWRITE(0, SE);
      ATT_RESC(alB); __syncthreads();
      ATT_SBAR(); qkt(pA0, pA1, K_lds, qr, r32, hi, dqn + (float)((j + 1) * 64), nsl2, -m_ref);
      finishSM(pB0, pB1, alB, l_reg, pa0, pa1, pa2, pa3); ATT_SBAR();
      if (j + 3 < NT) ATT_SLOAD(SE, (j + 3) * 64); ATT_SBAR();
      pv_d0(o, vb0 + SHM_V, pa0, pa1, pa2, pa3); partialSM<false>(pA0, pA1, m_ref, alA);
      __syncthreads(); ATT_SWAIT(); ATT_SWRITE(1, SO);
      ATT_RESC(alA); __syncthreads();
    }
    ATT_SBAR(); qkt(pB0, pB1, K_lds + SHM_K, qr, r32, hi, dqn + (float)((NT - 1) * 64), nsl2, -m_ref);
    finishSM(pA0, pA1, alA, l_reg, pa0, pa1, pa2, pa3); ATT_SBAR();
    pv_d0(o, vb0, pa0, pa1, pa2, pa3); partialSM<false>(pB0, pB1, m_ref, alB);
    __syncthreads(); ATT_RESC(alB);
    finishSM(pB0, pB1, alB, l_reg, pa0, pa1, pa2, pa3); ATT_SBAR();
    pv_d0(o, vb0 + SHM_V, pa0, pa1, pa2, pa3);
    if (hi == 0) li_l[r32] = l_reg; asm volatile("s_waitcnt lgkmcnt(0)" ::: "memory");
    float rli[16];
#pragma unroll
    for (int r = 0; r < 16; ++r) rli[r] = __builtin_amdgcn_rcpf(li_l[crow(r, hi)]);
    int hi_e = hi, r32_e = r32; asm volatile("" : "+v"(hi_e), "+v"(r32_e));
    const unsigned lo_e = (unsigned)(hi_e * 4096 + r32_e);
    if (n == 0) {
#pragma unroll
      for (int r = 0; r < 16; ++r) { const unsigned off = lo_e + (unsigned)(((r & 3) + 8 * (r >> 2)) * 1024);
#pragma unroll
        for (int d0 = 0; d0 < 4; ++d0) o1w[off + d0 * 32] = o[d0][r] * rli[r]; }
    } else {
      float gs[4];
#pragma unroll
      for (int d0 = 0; d0 < 4; ++d0) gs[d0] = gsub[d0 * 32 + r32_e] * onemli;
#pragma unroll
      for (int r = 0; r < 16; ++r) { const unsigned off = lo_e + (unsigned)(((r & 3) + 8 * (r >> 2)) * 1024); float dv[4]; float ss = 0.f;
#pragma unroll
        for (int d0 = 0; d0 < 4; ++d0) { dv[d0] = o1w[off + d0 * 32] - lam * (o[d0][r] * rli[r]); ss += dv[d0] * dv[d0]; }
        ss += __shfl_xor(ss, 1); ss += __shfl_xor(ss, 2); ss += __shfl_xor(ss, 4); ss += __shfl_xor(ss, 8); ss += __shfl_xor(ss, 16);
        const float rs = __builtin_amdgcn_rsqf(ss * (1.0f / 128.0f) + NORM_EPS);
#pragma unroll
        for (int d0 = 0; d0 < 4; ++d0) obw[off + d0 * 32] = (bf16_t)f2bf(dv[d0] * rs * gs[d0]);
        if ((r & 3) == 3) asm volatile("" ::: "memory"); }
    }
    __syncthreads();
#undef ATT_SLOAD
#undef ATT_SWRITE
#undef ATT_SWAIT
#undef ATT_RESC
  }
}
}

constexpr size_t MiB = 1u << 20;
constexpr size_t WS_CTL = 0, CTL_ZERO_BYTES = 1 * MiB;
constexpr size_t WS_MOD = 1 * MiB;
constexpr size_t WS_WSP = 2 * MiB;
constexpr size_t WS_AFF = 3 * MiB;
constexpr size_t WS_SLOT = 4 * MiB;
constexpr size_t WS_IDX = 5 * MiB;
constexpr size_t WS_W = 8 * MiB, W_LAYER = 212 * MiB;
constexpr size_t W_IN = 0, W_A = 14 * MiB, W_B = 16 * MiB, W_O = 18 * MiB, W_GU = 20 * MiB, W_D = 148 * MiB;
constexpr size_t WS_XN = WS_W + DEPTH * W_LAYER;
constexpr size_t WS_Z = WS_XN + 32 * MiB;
constexpr size_t WS_OB = WS_Z + 224 * MiB, WS_SG = WS_OB + 32 * MiB, WS_MRG = WS_SG + 32 * MiB;
constexpr size_t WS_Y = WS_MRG + 32 * MiB;
constexpr size_t WS_H2 = WS_Y + 64 * MiB;
constexpr size_t WS_XG = WS_H2 + 32 * MiB;
constexpr size_t WS_HID = WS_XG + 64 * MiB;
constexpr size_t WS_YC = WS_HID + 128 * MiB;
constexpr size_t WS_O1 = WS_YC + 64 * MiB;
constexpr size_t WS_END = WS_O1 + 64 * MiB;
constexpr int CW_BAR = 4096;
constexpr int RING_BYTES = 131072, LDSCTL_OFF = RING_BYTES, MISC_OFF = LDSCTL_OFF + 320, LDS_BYTES = 147456;
constexpr int NWAVES = 8;
constexpr int NPHASE = 2 + 10 * DEPTH;

typedef float f32x4g __attribute__((ext_vector_type(4)));
typedef unsigned u32x2 __attribute__((ext_vector_type(2)));

__device__ __forceinline__ float wave_sum(float v) {
#pragma unroll
    for (int o = 1; o < 64; o <<= 1) v += __shfl_xor(v, o);
    return v;
}
__device__ __forceinline__ float bflo(unsigned w) { return __builtin_bit_cast(float, w << 16); }
__device__ __forceinline__ float bfhi(unsigned w) { return __builtin_bit_cast(float, w & 0xffff0000u); }

__device__ __forceinline__ void tr_item(const float* W, int K, int N, bf16* WT, int k0, int n0, int drow0, LAS float* scr, int lane) {
#pragma unroll 8
    for (int i = 0; i < 32; ++i) { const int kk = 2 * i + (lane >> 5); scr[kk * 33 + (lane & 31)] = W[(size_t)(k0 + kk) * N + n0 + (lane & 31)]; }
    LDS_WAIT(); asm volatile("" ::: "memory");
    const int c = lane & 7;
#pragma unroll
    for (int j = 0; j < 4; ++j) { const int n = (lane >> 3) + 8 * j; const LAS float* s = scr + (8 * c) * 33 + n;
        v4u o; o.x = pk2(s[0 * 33], s[1 * 33]); o.y = pk2(s[2 * 33], s[3 * 33]); o.z = pk2(s[4 * 33], s[5 * 33]); o.w = pk2(s[6 * 33], s[7 * 33]);
        *(GAS v4u*)(WT + (size_t)(drow0 + n) * K + k0 + 8 * c) = o; }
    LDS_WAIT(); asm volatile("" ::: "memory");
}

__device__ __forceinline__ void modulate_store(const f32x4g (&v)[4], float rstd, const float* g, const float* sh, const float* sc, bf16* orow, int lane) {
#pragma unroll
    for (int j = 0; j < 4; ++j) { const int col = 4 * lane + 256 * j;
        const f32x4g gv = *(const f32x4g*)(g + col), sv = *(const f32x4g*)(sh + col), cv = *(const f32x4g*)(sc + col);
        const f32x4g h = v[j] * rstd * gv * (cv + 1.0f) + sv;
        u32x2 w; w.x = pk2(h.x, h.y); w.y = pk2(h.z, h.w); *(u32x2*)(orow + col) = w; }
}

#ifndef PH_EN
#define PH_EN(k) 1
#endif
struct Args { const float* in[26]; float* out; unsigned char* ws; int ph_lo, ph_hi, single, pad; };

__global__ void __launch_bounds__(NWAVES * 64, 2) mk_fwd(Args args) {
    extern __shared__ __attribute__((aligned(16))) unsigned char lds[];
    LAS unsigned char* const ldsl = (LAS unsigned char*)lds;
    volatile LAS unsigned* const MISC = (volatile LAS unsigned*)(ldsl + MISC_OFF);
    const int G = gridDim.x; const int bx = blockIdx.x; const int vcu = (G % 8 == 0) ? (bx % 8) * (G / 8) + bx / 8 : bx;
    const int NGW = G * NWAVES;
    unsigned char* ws_raw = args.ws;
    GAS unsigned char* ws = (GAS unsigned char*)ws_raw;
    gu32* const ctl = (gu32*)(ws + WS_CTL);
    for (int u = threadIdx.x; u < (LDS_BYTES - LDSCTL_OFF) / 4; u += NWAVES * 64) ((LAS unsigned*)(ldsl + LDSCTL_OFF))[u] = 0u;
    __syncthreads();
    XcdBarrier bar; bar.bar = (unsigned*)(ctl + CW_BAR); bar.x = 0; bar.st = nullptr;
    if (args.single) bar = xcd_barrier_post((unsigned*)(ctl + CW_BAR), MISC + 8);
    const int lo = args.ph_lo, hi = args.ph_hi;
#define IN(k) (lo <= (k) && (k) < hi)
#define PHASE_IDS() int tid_p = threadIdx.x; asm volatile("" : "+v"(tid_p)); const int tid = tid_p, lane = tid & 63, wave = __builtin_amdgcn_readfirstlane(tid >> 6), gw = vcu * NWAVES + wave; (void)lane; (void)gw
#define SEAM(k) do { if (args.single && (k) + 1 < hi) xcd_barrier(bar); } while (0)

#define MOD ((float*)(GAS float*)(ws + WS_MOD))
#define LAMV ((float*)(GAS float*)(ws + WS_MOD + 256 * 1024))
#define WSPB ((bf16*)(GAS bf16*)(ws + WS_WSP))
#define AFF ((float*)(GAS float*)(ws + WS_AFF))
#define SLOTMAP ((int*)(GAS int*)(ws + WS_SLOT))
#define IDX ((int*)(GAS int*)(ws + WS_IDX))
#define GATEV ((float*)(GAS float*)(ws + WS_IDX + 512 * 1024))
#define XN ((bf16*)(GAS bf16*)(ws + WS_XN))
#define ZB ((bf16*)(GAS bf16*)(ws + WS_Z))
#define QB ZB
#define KB (ZB + (size_t)M * 1024)
#define VB (ZB + 2 * (size_t)M * 1024)
#define UB (ZB + 3 * (size_t)M * 1024)
#define VGB (ZB + 4 * (size_t)M * 1024)
#define GAB (ZB + 5 * (size_t)M * 1024)
#define GBB (ZB + 6 * (size_t)M * 1024)
#define OB ((bf16*)(GAS bf16*)(ws + WS_OB))
#define SGB ((bf16*)(GAS bf16*)(ws + WS_SG))
#define MRG ((bf16*)(GAS bf16*)(ws + WS_MRG))
#define Y ((float*)(GAS float*)(ws + WS_Y))
#define H2 ((bf16*)(GAS bf16*)(ws + WS_H2))
#define XG ((bf16*)(GAS bf16*)(ws + WS_XG))
#define HID ((bf16*)(GAS bf16*)(ws + WS_HID))
#define YC ((bf16*)(GAS bf16*)(ws + WS_YC))
#define O1S ((float*)(GAS float*)(ws + WS_O1))
#define XOUT (args.out)

    if (PH_EN(0) && IN(0)) { PHASE_IDS();
        { LAS float* cact = (LAS float*)ldsl; LAS float* part = cact + 2048;
          const float* c = args.in[1];
          for (int i = tid; i < 2048; i += 512) { const float x = c[i]; cact[i] = x / (1.0f + __expf(-x)); }
          __syncthreads();
          for (int it = vcu; it < DEPTH * 96; it += G) {
              const int l = it / 96, cb = it % 96, col = cb * 64 + lane;
              const float* wp = args.in[2] + (size_t)l * 1024 * 6144 + (size_t)(wave * 128) * 6144 + col;
              float a0 = 0.f, a1 = 0.f;
#pragma unroll 8
              for (int k = 0; k < 128; ++k) { const float w = wp[(size_t)k * 6144]; a0 += cact[wave * 128 + k] * w; a1 += cact[1024 + wave * 128 + k] * w; }
              part[(wave * 2 + 0) * 64 + lane] = a0; part[(wave * 2 + 1) * 64 + lane] = a1;
              __syncthreads();
              if (wave < 2) { float s = 0.f;
#pragma unroll
                  for (int w8 = 0; w8 < 8; ++w8) s += part[(w8 * 2 + wave) * 64 + lane];
                  MOD[((size_t)l * BATCH + wave) * 6144 + col] = s + args.in[3][(size_t)l * 6144 + col]; }
              __syncthreads();
          }
          if (bx == 0 && tid < DEPTH) { const int l = tid; float d1 = 0.f, d2 = 0.f;
              for (int i = 0; i < 64; ++i) { d1 += args.in[7][l * 64 + i] * args.in[8][l * 64 + i]; d2 += args.in[9][l * 64 + i] * args.in[10][l * 64 + i]; }
              const float li = 0.8f - 0.6f * __expf(-0.3f * (float)l);
              LAMV[2 * l] = __expf(d1) - __expf(d2) + li; LAMV[2 * l + 1] = 1.0f - li; }
          __syncthreads();
        }
        { const float* wsp = args.in[14]; const int n8 = DEPTH * 8 * 128 * 128 / 8;
          for (int i = gw * 64 + lane; i < n8; i += NGW * 64) { const f32x4g a = *(const f32x4g*)(wsp + (size_t)i * 8), b = *(const f32x4g*)(wsp + (size_t)i * 8 + 4);
              v4u o; o.x = pk2(a.x, a.y); o.y = pk2(a.z, a.w); o.z = pk2(b.x, b.y); o.w = pk2(b.z, b.w); *(v4u*)(WSPB + (size_t)i * 8) = o; } }
        { LAS float* scr = (LAS float*)(ldsl + wave * 16384);
          constexpr int I_IN = 16 * 224, I_SQ = 16 * 32, I_GU = 16 * 64, I_DN = 32 * 32;
          constexpr int PER_LAYER = I_IN + 3 * I_SQ + 2 * NE * I_GU + NE * I_DN;
          for (int it = gw; it < DEPTH * PER_LAYER; it += NGW) {
              const int l = it / PER_LAYER; int r = it % PER_LAYER;
              GAS unsigned char* wl = ws + WS_W + (size_t)l * W_LAYER;
              if (r < I_IN) { const int kb = r / 224, nb = r % 224; tr_item(args.in[6] + (size_t)l * 1024 * NIN, 1024, NIN, (bf16*)(GAS bf16*)(wl + W_IN), kb * 64, nb * 32, nb * 32, scr, lane); continue; } r -= I_IN;
              if (r < 3 * I_SQ) { const int w = r / I_SQ, q = r % I_SQ, kb = q / 32, nb = q % 32;
                  tr_item(args.in[16 + w] + (size_t)l * 1024 * 1024, 1024, 1024, (bf16*)(GAS bf16*)(wl + (w == 0 ? W_A : w == 1 ? W_B : W_O)), kb * 64, nb * 32, nb * 32, scr, lane); continue; } r -= 3 * I_SQ;
              if (r < 2 * NE * I_GU) { const int up = r / (NE * I_GU), q = r % (NE * I_GU), e = q / I_GU, q2 = q % I_GU, kb = q2 / 64, nb = q2 % 64, n0 = nb * 32;
                  tr_item(args.in[23 + up] + ((size_t)l * NE + e) * 1024 * FF, 1024, FF, (bf16*)(GAS bf16*)(wl + W_GU), kb * 64, n0, e * 4096 + 256 * (n0 >> 7) + (n0 & 127) + up * 128, scr, lane); continue; } r -= 2 * NE * I_GU;
              { const int e = r / I_DN, q = r % I_DN, kb = q / 32, nb = q % 32;
                  tr_item(args.in[25] + ((size_t)l * NE + e) * FF * 1024, FF, 1024, (bf16*)(GAS bf16*)(wl + W_D), kb * 64, nb * 32, e * 1024 + nb * 32, scr, lane); }
          } }
        SEAM(0);
    }
    if (PH_EN(1) && IN(1)) { PHASE_IDS();
        for (int m = gw; m < M; m += NGW) { const int b = m / SEQ;
            const f32x4g* xr = (const f32x4g*)(args.in[0] + (size_t)m * D) + lane; f32x4g v[4]; float s = 0.f;
#pragma unroll
            for (int j = 0; j < 4; ++j) { v[j] = xr[64 * j]; s += (v[j].x * v[j].x + v[j].y * v[j].y) + (v[j].z * v[j].z + v[j].w * v[j].w); }
            const float rstd = __builtin_amdgcn_rsqf(wave_sum(s) * (1.f / D) + NORM_EPS);
            const float* md = MOD + (size_t)b * 6144;
            modulate_store(v, rstd, args.in[4], md + 0, md + 1024, XN + (size_t)m * D, lane); }
        SEAM(1);
    }

#pragma nounroll
    for (int l = 0; l < DEPTH; ++l) {
        const int pb = 2 + 10 * l;
        if (pb >= hi) break;
        asm volatile("" : "+s"(ws_raw)); ws = (GAS unsigned char*)ws_raw;
        GAS unsigned char* const wl = ws + WS_W + (size_t)l * W_LAYER;
        const float* const md0 = MOD + (size_t)l * BATCH * 6144;
        if (PH_EN(2) && IN(pb + 0)) {
            pg8::Gemm g{XN, (const bf16*)(GAS bf16*)(wl + W_IN), M, NIN, D}; pg8::StaticOrder S; S.init(M, NIN, G, bx);
            pg8::EpiIn E{ZB};
            pg8::gemm_phase<pg8::EpiIn, pg8::StaticOrder, true, true>(ldsl, g, S, E);
            SEAM(pb + 0);
        }
        if (PH_EN(3) && IN(pb + 1)) { PHASE_IDS();
            const float lam = LAMV[2 * l], onemli = LAMV[2 * l + 1];
            if (PH_EN(12)) for (int i = 0; i < 2; ++i) { const int uid = i * G + vcu; if (uid >= BATCH * NHEAD * 32) break;
                const int bh = uid >> 5, qb = uid & 31;
                att::attn_unit(bh >> 3, bh & 7, qb, QB, KB, VB, OB, O1S, lam, onemli, args.in[11] + l * 128, (char*)lds); }
            if (PH_EN(13)) for (int uid = vcu; uid < (M / 128) * 2; uid += G) {
                const int ch = uid >> 1, gh = uid & 1; const size_t tok0 = (size_t)ch * 128;
                LAS float* st = (LAS float*)(ldsl + 65536);
                for (int rr = 0; rr < 16; ++rr) { const int row = wave * 16 + rr; const bf16* vp = VGB + (tok0 + row) * 1024 + lane * 8;
                    const v4u a = *(const v4u*)vp, b2 = *(const v4u*)(vp + 512);
                    float x[16] = {bflo(a.x), bfhi(a.x), bflo(a.y), bfhi(a.y), bflo(a.z), bfhi(a.z), bflo(a.w), bfhi(a.w), bflo(b2.x), bfhi(b2.x), bflo(b2.y), bfhi(b2.y), bflo(b2.z), bfhi(b2.z), bflo(b2.w), bfhi(b2.w)};
                    float s = 0.f;
#pragma unroll
                    for (int q = 0; q < 16; ++q) s += x[q];
                    const float mean = wave_sum(s) * (1.f / 1024.f); float s2 = 0.f;
#pragma unroll
                    for (int q = 0; q < 16; ++q) { const float d = x[q] - mean; s2 += d * d; }
                    const float rstd = __builtin_amdgcn_rsqf(wave_sum(s2) * (1.f / 1024.f) + NORM_EPS);
                    if (lane == 0) { st[row * 2] = mean; st[row * 2 + 1] = rstd; } }
                __syncthreads();
                for (int gp = 0; gp < 2; ++gp) {
                    const int sr = tid >> 4, sc = (tid & 15) * 8;
#pragma unroll
                    for (int gs = 0; gs < 2; ++gs) { const int g = gh * 4 + gp * 2 + gs; const int colg = g * 128 + sc;
                        const f32x4g lg0 = *(const f32x4g*)(args.in[12] + l * 1024 + colg), lg1 = *(const f32x4g*)(args.in[12] + l * 1024 + colg + 4);
                        const f32x4g lb0 = *(const f32x4g*)(args.in[13] + l * 1024 + colg), lb1 = *(const f32x4g*)(args.in[13] + l * 1024 + colg + 4);
#pragma unroll
                        for (int q = 0; q < 4; ++q) { const int row = sr + 32 * q; const v4u a = *(const v4u*)(VGB + (tok0 + row) * 1024 + colg);
                            const float mean = st[row * 2], rstd = st[row * 2 + 1];
                            v4u o; o.x = pk2((bflo(a.x) - mean) * rstd * lg0.x + lb0.x, (bfhi(a.x) - mean) * rstd * lg0.y + lb0.y);
                            o.y = pk2((bflo(a.y) - mean) * rstd * lg0.z + lb0.z, (bfhi(a.y) - mean) * rstd * lg0.w + lb0.w);
                            o.z = pk2((bflo(a.z) - mean) * rstd * lg1.x + lb1.x, (bfhi(a.z) - mean) * rstd * lg1.y + lb1.y);
                            o.w = pk2((bflo(a.w) - mean) * rstd * lg1.z + lb1.z, (bfhi(a.w) - mean) * rstd * lg1.w + lb1.w);
                            *(LAS v4u*)(ldsl + gs * 32768 + (row >> 6) * 16384 + att::v_st(row & 63, sc)) = o; } }
                    __syncthreads();
                    { const int gs = wave >> 2, tb = wave & 3, g = gh * 4 + gp * 2 + gs, r32 = lane & 31, hi2 = lane >> 5;
                      const bf16* wp = WSPB + (((size_t)l * 8 + g) * 128 + tb * 32 + r32) * 128 + hi2 * 8;
                      att::bf16x8 pa[8];
#pragma unroll
                      for (int ks = 0; ks < 8; ++ks) pa[ks] = *(const att::bf16x8*)(wp + ks * 16);
                      att::f32x16 o[4] = {};
                      const int vb = (int)(uintptr_t)(lds + gs * 32768) + att::v_rd_base(lane);
                      att::pv_d0(o, vb, pa[0], pa[1], pa[2], pa[3]);
                      att::pv_d0(o, vb + 16384, pa[4], pa[5], pa[6], pa[7]);
                      const float* bsp = args.in[15] + ((size_t)l * 8 + g) * 128 + tb * 32;
#pragma unroll
                      for (int r = 0; r < 16; ++r) { const int t = att::crow(r, hi2); const float bsv = bsp[t]; const size_t off = (tok0 + tb * 32 + t) * 1024 + g * 128 + r32;
#pragma unroll
                          for (int d0 = 0; d0 < 4; ++d0) { const float uu = __builtin_bit_cast(float, (unsigned)UB[off + d0 * 32] << 16); SGB[off + d0 * 32] = (bf16)f2bf(uu * (o[d0][r] + bsv)); } } }
                    __syncthreads();
                }
            }
            SEAM(pb + 1);
        }
        if (PH_EN(4) && IN(pb + 2)) {
            { pg8::Gemm g{OB, (const bf16*)(GAS bf16*)(wl + W_A), M, D, D}; pg8::StaticOrder S; S.init(M, D, G, bx); pg8::EpiGate<false> E{GAB, MRG};
              pg8::gemm_phase<pg8::EpiGate<false>, pg8::StaticOrder, true, true>(ldsl, g, S, E); }
            asm volatile("s_waitcnt vmcnt(0) lgkmcnt(0)\n\ts_barrier" ::: "memory");
            { pg8::Gemm g{SGB, (const bf16*)(GAS bf16*)(wl + W_B), M, D, D}; pg8::StaticOrder S; S.init(M, D, G, bx); pg8::EpiGate<true> E{GBB, MRG};
              pg8::gemm_phase<pg8::EpiGate<true>, pg8::StaticOrder, true, true>(ldsl, g, S, E); }
            SEAM(pb + 2);
        }
        if (PH_EN(5) && IN(pb + 3)) {
            pg8::Gemm g{MRG, (const bf16*)(GAS bf16*)(wl + W_O), M, D, D}; pg8::StaticOrder S; S.init(M, D, G, bx); pg8::EpiF32 E{Y};
            pg8::gemm_phase<pg8::EpiF32, pg8::StaticOrder, true, true>(ldsl, g, S, E);
            SEAM(pb + 3);
        }
        if (PH_EN(6) && IN(pb + 4)) { PHASE_IDS();
            LAS float* wr = (LAS float*)ldsl;
            { const float* wrg = args.in[21] + (size_t)l * 1024 * NE;
              for (int i = tid; i < 1024 * NE; i += 512) wr[(i & 15) * 1024 + (i >> 4)] = wrg[i]; }
            __syncthreads();
            const float* xin = (l == 0) ? args.in[0] : XOUT;
            const int e_l = ((lane >> 5) & 1) * 8 + ((lane >> 4) & 1) * 4 + ((lane >> 3) & 1) * 2 + ((lane >> 2) & 1);
            const float br = args.in[22][l * NE + e_l];
            for (int m = gw; m < M; m += NGW) { const int b = m / SEQ; const float* md = md0 + (size_t)b * 6144;
                const f32x4g* yr = (const f32x4g*)(Y + (size_t)m * D) + lane; const f32x4g* xr = (const f32x4g*)(xin + (size_t)m * D) + lane;
                f32x4g v[4]; float s = 0.f;
#pragma unroll
                for (int j = 0; j < 4; ++j) { v[j] = yr[64 * j]; s += (v[j].x * v[j].x + v[j].y * v[j].y) + (v[j].z * v[j].z + v[j].w * v[j].w); }
                const float rstd = __builtin_amdgcn_rsqf(wave_sum(s) * (1.f / D) + NORM_EPS); float s2 = 0.f;
#pragma unroll
                for (int j = 0; j < 4; ++j) { const int col = 4 * lane + 256 * j;
                    const f32x4g gp = *(const f32x4g*)(args.in[5] + l * 1024 + col), gt = *(const f32x4g*)(md + 2048 + col);
                    v[j] = xr[64 * j] + gt * (v[j] * rstd * gp);
                    *((f32x4g*)(XOUT + (size_t)m * D) + lane + 64 * j) = v[j];
                    s2 += (v[j].x * v[j].x + v[j].y * v[j].y) + (v[j].z * v[j].z + v[j].w * v[j].w); }
                const float rstd2 = __builtin_amdgcn_rsqf(wave_sum(s2) * (1.f / D) + NORM_EPS);
                float acc[16];
#pragma unroll
                for (int e = 0; e < 16; ++e) acc[e] = 0.f;
#pragma unroll
                for (int j = 0; j < 4; ++j) { const int col = 4 * lane + 256 * j;
                    const f32x4g gv = *(const f32x4g*)(args.in[19] + l * 1024 + col), sv = *(const f32x4g*)(md + 3072 + col), cv = *(const f32x4g*)(md + 4096 + col);
                    const f32x4g h = v[j] * rstd2 * gv * (cv + 1.0f) + sv;
                    u32x2 w; w.x = pk2(h.x, h.y); w.y = pk2(h.z, h.w); *(u32x2*)(H2 + (size_t)m * D + col) = w;
#pragma unroll
                    for (int e = 0; e < 16; ++e) { const f32x4g wv = *(const LAS f32x4g*)(wr + e * 1024 + col); acc[e] += (h.x * wv.x + h.y * wv.y) + (h.z * wv.z + h.w * wv.w);
                        if ((e & 3) == 3) asm volatile("" ::: "memory"); } }
#pragma unroll
                for (int st = 0; st < 4; ++st) { const int sh = 32 >> st, half = 8 >> st; const bool up = (lane & sh) != 0;
#pragma unroll
                    for (int i = 0; i < half; ++i) { const float keep = up ? acc[i + half] : acc[i], send = up ? acc[i] : acc[i + half]; acc[i] = keep + __shfl_xor(send, sh); } }
                float lg = acc[0]; lg += __shfl_xor(lg, 2); lg += __shfl_xor(lg, 1); lg += br;
                float mx = lg; mx = fmaxf(mx, __shfl_xor(mx, 32)); mx = fmaxf(mx, __shfl_xor(mx, 16)); mx = fmaxf(mx, __shfl_xor(mx, 8)); mx = fmaxf(mx, __shfl_xor(mx, 4));
                const float ex = __expf(lg - mx); float sm = ex; sm += __shfl_xor(sm, 32); sm += __shfl_xor(sm, 16); sm += __shfl_xor(sm, 8); sm += __shfl_xor(sm, 4);
                if ((lane & 3) == 0) AFF[(size_t)m * NE + e_l] = ex / sm;
                if (lane < 16) SLOTMAP[(size_t)m * NE + lane] = 0;
            }
            SEAM(pb + 4);
        }
        if (PH_EN(7) && IN(pb + 5)) { PHASE_IDS();
            for (int uid = vcu; uid < BATCH * NE; uid += G) { const int b = uid / NE, e = uid % NE;
                LAS unsigned* hist = (LAS unsigned*)ldsl; LAS unsigned* sh = hist + 256;
                float v[16]; unsigned bits[16]; const int t0 = tid * 16;
#pragma unroll
                for (int i = 0; i < 16; ++i) { v[i] = AFF[((size_t)b * SEQ + t0 + i) * NE + e]; bits[i] = __float_as_uint(v[i]); }
                unsigned pref = 0, need = CAP;
#pragma nounroll
                for (int pass = 0; pass < 4; ++pass) { const int shift = 24 - 8 * pass;
                    if (tid < 256) hist[tid] = 0u; __syncthreads();
#pragma unroll
                    for (int i = 0; i < 16; ++i) { const bool in = (unsigned)((unsigned long long)bits[i] >> (shift + 8)) == pref; if (in) atomicAdd((unsigned*)&hist[(bits[i] >> shift) & 255u], 1u); }
                    __syncthreads();
                    if (wave == 0) { const unsigned h0 = hist[4 * lane], h1 = hist[4 * lane + 1], h2 = hist[4 * lane + 2], h3 = hist[4 * lane + 3]; const unsigned c = h0 + h1 + h2 + h3;
                        unsigned s = c;
#pragma unroll
                        for (int o = 1; o < 64; o <<= 1) { const unsigned t = __shfl_down(s, o); if (lane + o < 64) s += t; }
                        const unsigned above = s - c;
                        if (above < need && need <= s) { unsigned a = above; unsigned dsel, nn;
                            if (a + h3 >= need) { dsel = 3; nn = need - a; } else { a += h3;
                            if (a + h2 >= need) { dsel = 2; nn = need - a; } else { a += h2;
                            if (a + h1 >= need) { dsel = 1; nn = need - a; } else { a += h1; dsel = 0; nn = need - a; } } }
                            sh[0] = 4 * lane + dsel; sh[1] = nn; } }
                    __syncthreads();
                    pref = (pref << 8) | sh[0]; need = sh[1];
                    __syncthreads();
                }
                const unsigned thr = pref; unsigned ngt = 0, neq = 0;
#pragma unroll
                for (int i = 0; i < 16; ++i) { ngt += bits[i] > thr ? 1u : 0u; neq += bits[i] == thr ? 1u : 0u; }
                const unsigned packed = ngt | (neq << 16); unsigned inc = packed;
#pragma unroll
                for (int o = 1; o < 64; o <<= 1) { const unsigned t = __shfl_up(inc, o); if (lane >= o) inc += t; }
                if (lane == 63) sh[8 + wave] = inc; __syncthreads();
                unsigned wbase = 0;
                for (int w = 0; w < wave; ++w) wbase += sh[8 + w];
                const unsigned exc = wbase + inc - packed; unsigned gtb = exc & 0xffffu, eqb = exc >> 16;
#pragma unroll
                for (int i = 0; i < 16; ++i) { const bool gt = bits[i] > thr, eq = bits[i] == thr;
                    if (gt || (eq && eqb < need)) { const unsigned slot = gtb + (eqb < need ? eqb : need); const int row = e * 2048 + b * 1024 + (int)slot; const int tok = b * SEQ + t0 + i;
                        IDX[row] = tok; GATEV[row] = v[i]; SLOTMAP[(size_t)tok * NE + e] = row + 1; }
                    gtb += gt ? 1u : 0u; eqb += eq ? 1u : 0u; }
                __syncthreads();
            }
            SEAM(pb + 5);
        }
        if (PH_EN(8) && IN(pb + 6)) { PHASE_IDS();
            for (int r = gw; r < NSEL; r += NGW) { const int tok = IDX[r]; const v4u* src = (const v4u*)(H2 + (size_t)tok * D) + lane; v4u* dst = (v4u*)(XG + (size_t)r * D) + lane;
                const v4u a = src[0], b2 = src[64]; dst[0] = a; dst[64] = b2; }
            SEAM(pb + 6);
        }
        if (PH_EN(9) && IN(pb + 7)) {
            pg8::Gemm g{XG, (const bf16*)(GAS bf16*)(wl + W_GU), NSEL, NE * 4096, D}; pg8::MoeOrder1 S{vcu, G}; pg8::EpiMoe1 E{HID};
            pg8::gemm_phase<pg8::EpiMoe1, pg8::MoeOrder1, true, true>(ldsl, g, S, E);
            SEAM(pb + 7);
        }
        if (PH_EN(10) && IN(pb + 8)) {
            pg8::Gemm g{HID, (const bf16*)(GAS bf16*)(wl + W_D), NSEL, NE * 1024, FF}; pg8::MoeOrder2 S{vcu, G}; pg8::EpiMoe2 E{YC, GATEV};
            pg8::gemm_phase<pg8::EpiMoe2, pg8::MoeOrder2, true, true>(ldsl, g, S, E);
            SEAM(pb + 8);
        }
        if (PH_EN(11) && IN(pb + 9)) { PHASE_IDS();
            for (int m = gw; m < M; m += NGW) { const int b = m / SEQ; const float* md = md0 + (size_t)b * 6144;
                const int sm = SLOTMAP[(size_t)m * NE + (lane & 15)];
                f32x4g y[4];
#pragma unroll
                for (int j = 0; j < 4; ++j) y[j] = (f32x4g){0.f, 0.f, 0.f, 0.f};
                for (int e = 0; e < NE; ++e) { const int row1 = __shfl(sm, e); if (row1 != 0) { const u32x2* yp = (const u32x2*)(YC + (size_t)(row1 - 1) * D) + lane;
#pragma unroll
                    for (int j = 0; j < 4; ++j) { const u32x2 w = yp[64 * j]; y[j] += (f32x4g){bflo(w.x), bfhi(w.x), bflo(w.y), bfhi(w.y)}; } } }
                float s = 0.f;
#pragma unroll
                for (int j = 0; j < 4; ++j) s += (y[j].x * y[j].x + y[j].y * y[j].y) + (y[j].z * y[j].z + y[j].w * y[j].w);
                const float rstd = __builtin_amdgcn_rsqf(wave_sum(s) * (1.f / D) + NORM_EPS); float s2 = 0.f;
                f32x4g* xr = (f32x4g*)(XOUT + (size_t)m * D) + lane; f32x4g v[4];
#pragma unroll
                for (int j = 0; j < 4; ++j) { const int col = 4 * lane + 256 * j;
                    const f32x4g gp = *(const f32x4g*)(args.in[20] + l * 1024 + col), gt = *(const f32x4g*)(md + 5120 + col);
                    v[j] = xr[64 * j] + gt * (y[j] * rstd * gp); xr[64 * j] = v[j];
                    s2 += (v[j].x * v[j].x + v[j].y * v[j].y) + (v[j].z * v[j].z + v[j].w * v[j].w); }
                if (l + 1 < DEPTH) { const float rstd2 = __builtin_amdgcn_rsqf(wave_sum(s2) * (1.f / D) + NORM_EPS); const float* mdn = md + (size_t)BATCH * 6144;
                    modulate_store(v, rstd2, args.in[4] + (l + 1) * 1024, mdn + 0, mdn + 1024, XN + (size_t)m * D, lane); }
            }
            SEAM(pb + 9);
        }
    }
#undef IN
#undef SEAM
}

#ifndef MK_SINGLE
#define MK_SINGLE 0
#endif
extern "C" void kernel_launch(void* const* d_in, const int* in_sizes, int n_in, void* d_out, int out_size, void* d_ws, size_t ws_size, hipStream_t stream) {
    static int grid = 0;
    if (grid == 0) {
        if (n_in != 26 || in_sizes[0] != M * D || out_size != M * D || ws_size < WS_END) { fprintf(stderr, "kernel_launch: unexpected shapes (n_in %d, in0 %d, out %d, ws %zu < %zu); nothing launched\n", n_in, n_in > 0 ? in_sizes[0] : -1, out_size, ws_size, (size_t)WS_END); grid = -1; return; }
        int dev = 0, cus = 0, per_cu = 0;
        if (hipGetDevice(&dev) != hipSuccess || hipDeviceGetAttribute(&cus, hipDeviceAttributeMultiprocessorCount, dev) != hipSuccess) { grid = -1; return; }
        if (hipFuncSetAttribute((const void*)mk_fwd, hipFuncAttributeMaxDynamicSharedMemorySize, LDS_BYTES) != hipSuccess) { fprintf(stderr, "kernel_launch: hipFuncSetAttribute failed\n"); grid = -1; return; }
        if (hipOccupancyMaxActiveBlocksPerMultiprocessor(&per_cu, (const void*)mk_fwd, NWAVES * 64, LDS_BYTES) != hipSuccess || per_cu < 1) { fprintf(stderr, "kernel_launch: occupancy query says %d\n", per_cu); }
        (void)hipGetLastError();
        grid = cus;
    }
    if (grid < 0) return;
    (void)hipMemsetAsync((char*)d_ws + WS_CTL, 0, CTL_ZERO_BYTES, stream);
    Args a{};
    for (int i = 0; i < 26; ++i) a.in[i] = (const float*)d_in[i];
    a.out = (float*)d_out; a.ws = (unsigned char*)d_ws; a.pad = 0;
#if MK_SINGLE
    a.ph_lo = 0; a.ph_hi = NPHASE; a.single = 1;
    hipLaunchKernelGGL(mk_fwd, dim3(grid), dim3(NWAVES * 64), LDS_BYTES, stream, a);
#else
    a.single = 0;
#ifndef MK_PROBE_STOP
#define MK_PROBE_STOP NPHASE
#endif
    for (int p = 0; p < MK_PROBE_STOP; ++p) { a.ph_lo = p; a.ph_hi = p + 1; hipLaunchKernelGGL(mk_fwd, dim3(grid), dim3(NWAVES * 64), LDS_BYTES, stream, a); }
#ifdef MK_PROBE_COPY_OFF
    (void)hipMemcpyAsync(d_out, (char*)d_ws + (MK_PROBE_COPY_OFF), (size_t)M * D * 4, hipMemcpyDeviceToDevice, stream);
#endif
#endif
}
```

```cpp
#include <hip/hip_runtime.h>
#include <hip/hip_bf16.h>
#include <cstdio>
#include <cstdint>
namespace pg8 {
#define PG8_LAS __attribute__((address_space(3)))
typedef unsigned short bf16_t;
typedef short bf16x8 __attribute__((ext_vector_type(8)));
typedef float f32x4 __attribute__((ext_vector_type(4)));
typedef unsigned u32x4 __attribute__((ext_vector_type(4)));
constexpr int BM = 256, BK = 64, HALF = 128, HTB = HALF * BK * 2  , STAGE_BYTES = 8 * HTB, NXCD = 8, WGM = 8;

__host__ __device__ __forceinline__ int lds_byte(int r, int c) { const int st = (r >> 4) * 2 + (c >> 5), rr = r & 15, cc = c & 31, ob = rr * 64 + cc * 2; return st * 1024 + (ob ^ (((ob >> 9) & 1) << 5)); }
__host__ __device__ __forceinline__ void stage_rc(int b, int& R, int& C) { const int st = b / 1024, sb = b % 1024, swz = sb ^ (((sb >> 9) & 1) << 5); R = (st >> 1) * 16 + swz / 64; C = (st & 1) * 32 + (swz % 64) / 2; }
__host__ __device__ __forceinline__ int perm32(int rho) { const int n = rho >> 4, i = rho & 15; return 8 * (i >> 2) + 4 * n + (i & 3); }

struct Unit { int pm, pn; };
struct Gemm { const bf16_t* A; const bf16_t* Bt; int M, N, K; };

struct StaticOrder {
    int nM, nN, nwg, G, c;
    __host__ __device__ void init(int M, int N, int G_, int c_) { nM = M / BM; nN = N / BM; nwg = nM * nN; G = G_; c = c_; }
    __host__ __device__ bool next(int i, Unit& u) const {
        const long L = (long)i * G + c; if (L >= nwg) return false;
        int wgid = (int)L; { const int q = nwg / NXCD, r = nwg % NXCD, xcd = wgid % NXCD, off = wgid / NXCD; wgid = (xcd < r ? xcd * (q + 1) : r * (q + 1) + (xcd - r) * q) + off; }
        const int nig = WGM * nN, gid = wgid / nig, fm = gid * WGM, gsz = (nM - fm) < WGM ? (nM - fm) : WGM;
        u.pm = fm + ((wgid % nig) % gsz); u.pn = (wgid % nig) / gsz; return true;
    }
    __device__ __forceinline__ void a_ready(const Unit&) const {}
    __device__ __forceinline__ void done(const Unit&) const {}
};

typedef float f32x2c_t __attribute__((ext_vector_type(2))); typedef __bf16 bf16x2c_t __attribute__((ext_vector_type(2)));
__device__ __forceinline__ unsigned cvt_pk_bf16(float lo, float hi) { f32x2c_t v = {lo, hi}; bf16x2c_t b = __builtin_convertvector(v, bf16x2c_t); return __builtin_bit_cast(unsigned, b); }
typedef float f32x2 __attribute__((ext_vector_type(2)));
__device__ __forceinline__ f32x2 gelu_pk(f32x2 v) {
    const f32x2 av = __builtin_elementwise_abs(v), d = av * 0.2316418882f + 1.0f;
    f32x2 t; t.x = __builtin_amdgcn_rcpf(d.x); t.y = __builtin_amdgcn_rcpf(d.y);
    f32x2 q = t * 0.5307027145f + (-0.7265760135f); q = q * t + 0.7107068705f; q = q * t + (-0.142248368f); q = q * t + 0.127414796f; q = q * t;
    const f32x2 s = (v * v) * (-0.72134752044f);
    f32x2 e; e.x = __builtin_amdgcn_exp2f(s.x); e.y = __builtin_amdgcn_exp2f(s.y);
    const f32x2 m = v * (q * e), r = v - m;
    f32x2 o; o.x = v.x < 0.f ? m.x : r.x; o.y = v.y < 0.f ? m.y : r.y; return o;
}

template <class Epi, class Sched, bool ALIGN_EPI = false, bool SP2 = false, bool GATHER = false, int BAUX = 0  ,
          int F8 = 0  >
__device__ __forceinline__ void gemm_phase(PG8_LAS unsigned char* lds, const Gemm g, const Sched& S, const Epi& E, const int wid_in  , const PG8_LAS int* tokl = nullptr) {
    int lane_; asm volatile("v_mbcnt_lo_u32_b32 %0, -1, 0\n\tv_mbcnt_hi_u32_b32 %0, -1, %0" : "=v"(lane_));
    const int wid = wid_in, lane = lane_, tid = wid * 64 + lane, wr = wid >> 2, wc = wid & 3, fr = lane & 15, fq = lane >> 4;
    const int K = g.K, nt = K / BK;
    unsigned voffA[2], voffB[2];
    int RA[2], CA[2];
#pragma unroll
    for (int i = 0; i < 2; ++i) { int R, C; stage_rc(tid * 16 + i * 8192, R, C); const int Rb = Epi::PERM ? ((R & ~31) + perm32(R & 31)) : R; RA[i] = R; CA[i] = C;
        voffA[i] = (unsigned)(R * K + C) * 2u; voffB[i] = (unsigned)(Rb * K + C) * 2u; }
    unsigned gA0[2] = {0u, 0u}, gA1[2] = {0u, 0u}, gN0[2] = {0u, 0u}, gN1[2] = {0u, 0u};
#define PG8_GLOAD(d0_, d1_, ui_) do { _Pragma("unroll") for (int i_ = 0; i_ < 2; ++i_) { d0_[i_] = (unsigned)tokl[(ui_) * 256 + RA[i_]] * (unsigned)(K * 2) + (unsigned)(CA[i_] * 2); \
        d1_[i_] = (unsigned)tokl[(ui_) * 256 + 128 + RA[i_]] * (unsigned)(K * 2) + (unsigned)(CA[i_] * 2); } } while (0)
    const size_t kstep = (size_t)(BK * 2);
    const size_t hstep = (size_t)HALF * K * 2;
    const size_t hstepA = GATHER ? (size_t)0 : hstep;
    const size_t tstep = 2 * hstep;
    const unsigned ldsw = (unsigned)wid * 1024u;
    const int aoff = lds_byte(wr * 64 + fr, F8 == 2 ? fq * 16 : fq * 8), boff = lds_byte(wc * 32 + fr, F8 == 2 ? fq * 16 : fq * 8);
    constexpr int kfr = F8 == 2 ? 16 : 1024;
    int sc1_ = 127; asm volatile("" : "+v"(sc1_));
#define PG8_SA(b, h) (((b) * 2 + (h)) * HTB)
#define PG8_SB(b, h) ((4 + (b) * 2 + (h)) * HTB)
    const size_t rstep = (size_t)64 * K * 2;
#define PG8_STAGE(bufoff, gbase, voff) do { _Pragma("unroll") for (int _i = 0; _i < 2; ++_i) \
        __builtin_amdgcn_global_load_lds((const unsigned*)((const char*)(gbase) + (GATHER ? (size_t)0 : (size_t)_i * rstep) + (voff)[GATHER ? _i : 0]), (PG8_LAS unsigned*)(lds + (bufoff) + ldsw + _i * 8192), 16, 0, 0); } while (0)
#define PG8_STAGEB(bufoff, gbase, voff) do { _Pragma("unroll") for (int _i = 0; _i < 2; ++_i) \
        __builtin_amdgcn_global_load_lds((const unsigned*)((const char*)(gbase) + (size_t)_i * rstep + (voff)[0]), (PG8_LAS unsigned*)(lds + (bufoff) + ldsw + _i * 8192), 16, 0, BAUX); } while (0)
#define PG8_LDA(dst, b, h) do { _Pragma("unroll") for (int m = 0; m < 4; ++m) _Pragma("unroll") for (int k = 0; k < 2; ++k) dst[m][k] = *(const PG8_LAS bf16x8*)(lds + PG8_SA(b, h) + aoff + m * 2048 + k * kfr); } while (0)
#define PG8_LDB(dst, b, h) do { _Pragma("unroll") for (int n = 0; n < 2; ++n) _Pragma("unroll") for (int k = 0; k < 2; ++k) dst[n][k] = *(const PG8_LAS bf16x8*)(lds + PG8_SB(b, h) + boff + n * 2048 + k * kfr); } while (0)
typedef long pg8_i64x2 __attribute__((ext_vector_type(2)));
typedef int pg8_i32x4 __attribute__((ext_vector_type(4))); typedef int pg8_i32x8 __attribute__((ext_vector_type(8)));
#define PG8_CAT8(lo_, hi_) __builtin_shufflevector(__builtin_bit_cast(pg8_i32x4, lo_), __builtin_bit_cast(pg8_i32x4, hi_), 0, 1, 2, 3, 4, 5, 6, 7)
#define PG8_MMA(ai, bj, At, Bt) do { __builtin_amdgcn_s_setprio(1); if constexpr (F8 == 2) { _Pragma("unroll") for (int m = 0; m < 4; ++m) _Pragma("unroll") for (int n = 0; n < 2; ++n) { \
        const pg8_i32x8 w_ = PG8_CAT8(Bt[n][0], Bt[n][1]), x_ = PG8_CAT8(At[m][0], At[m][1]); \
        asm volatile("v_mfma_scale_f32_16x16x128_f8f6f4 %0, %1, %2, %0, %3, %3 op_sel_hi:[0,0,0]" : "+v"(acc[ai][bj][m][n]) : "v"(w_), "v"(x_), "v"(sc1_)); } } else if constexpr (F8 != 0) { _Pragma("unroll") for (int m = 0; m < 4; ++m) _Pragma("unroll") for (int n = 0; n < 2; ++n) _Pragma("unroll") for (int k = 0; k < 2; ++k) { \
        const pg8_i64x2 w_ = __builtin_bit_cast(pg8_i64x2, Bt[n][k]), x_ = __builtin_bit_cast(pg8_i64x2, At[m][k]); \
        acc[ai][bj][m][n] = __builtin_amdgcn_mfma_f32_16x16x32_fp8_fp8(w_[0], x_[0], acc[ai][bj][m][n], 0, 0, 0); acc[ai][bj][m][n] = __builtin_amdgcn_mfma_f32_16x16x32_fp8_fp8(w_[1], x_[1], acc[ai][bj][m][n], 0, 0, 0); } } else { \
        _Pragma("unroll") for (int m = 0; m < 4; ++m) _Pragma("unroll") for (int n = 0; n < 2; ++n) _Pragma("unroll") for (int k = 0; k < 2; ++k) \
        acc[ai][bj][m][n] = __builtin_amdgcn_mfma_f32_16x16x32_bf16(Bt[n][k], At[m][k], acc[ai][bj][m][n], 0, 0, 0); } __builtin_amdgcn_s_setprio(0); } while (0)
#define PG8_WAIT_V(n) asm volatile("s_waitcnt vmcnt(" #n ")" ::: "memory")
#define PG8_WAIT_L(n) asm volatile("s_waitcnt lgkmcnt(" #n ")" ::: "memory")
#define PG8_BAR __builtin_amdgcn_s_barrier()
#define PG8_SCHED __builtin_amdgcn_sched_barrier(0)
    Unit cur, nxt; int ui = 0;
    if (!S.next(0, cur)) return;
    f32x4 acc[2][2][4][2];
#pragma unroll
    for (int a = 0; a < 2; ++a)
#pragma unroll
        for (int b = 0; b < 2; ++b)
#pragma unroll
            for (int m = 0; m < 4; ++m)
#pragma unroll
                for (int n = 0; n < 2; ++n) acc[a][b][m][n] = (f32x4){0.f, 0.f, 0.f, 0.f};
    bf16x8 At[4][2], B0[2][2], B1[2][2];
    const char* cA = GATHER ? (const char*)g.A : (const char*)g.A + (size_t)cur.pm * tstep; const char* cB = (const char*)g.Bt + (size_t)cur.pn * tstep;
    if constexpr (GATHER) PG8_GLOAD(gA0, gA1, 0);
#define PG8_VA0 (GATHER ? gA0 : voffA)
#define PG8_VA1 (GATHER ? gA1 : voffA)
    S.a_ready(cur);
    if constexpr (SP2) {
        PG8_STAGEB(PG8_SB(0, 0), cB, voffB); PG8_STAGEB(PG8_SB(0, 1), cB + hstep, voffB); PG8_STAGE(PG8_SA(0, 0), cA, PG8_VA0); PG8_STAGE(PG8_SA(0, 1), cA + hstepA, PG8_VA1);
        if (wr == 1) PG8_BAR;
        PG8_WAIT_V(2); PG8_BAR;
        PG8_STAGEB(PG8_SB(1, 0), cB + kstep, voffB); PG8_STAGE(PG8_SA(1, 0), cA + kstep, PG8_VA0); PG8_STAGEB(PG8_SB(1, 1), cB + hstep + kstep, voffB);
        PG8_WAIT_V(6); PG8_BAR;
    } else {
        PG8_STAGEB(PG8_SB(0, 0), cB, voffB); PG8_STAGE(PG8_SA(0, 0), cA, PG8_VA0); PG8_STAGEB(PG8_SB(0, 1), cB + hstep, voffB); PG8_STAGE(PG8_SA(0, 1), cA + hstepA, PG8_VA1);
        if (wr == 1) PG8_BAR;
        PG8_WAIT_V(4); PG8_BAR;
        PG8_STAGEB(PG8_SB(1, 0), cB + kstep, voffB); PG8_STAGE(PG8_SA(1, 0), cA + kstep, PG8_VA0); PG8_STAGEB(PG8_SB(1, 1), cB + hstep + kstep, voffB);
        PG8_WAIT_V(6); PG8_BAR;
    }
    for (;;) {
        const bool has_next = S.next(ui + 1, nxt);
        const char* nA = has_next ? (GATHER ? (const char*)g.A : (const char*)g.A + (size_t)nxt.pm * tstep) : cA; const char* nB = has_next ? (const char*)g.Bt + (size_t)nxt.pn * tstep : cB;
        if constexpr (GATHER) { if (has_next) PG8_GLOAD(gN0, gN1, ui + 1); else { gN0[0] = gA0[0]; gN0[1] = gA0[1]; gN1[0] = gA1[0]; gN1[1] = gA1[1]; } }
#define PG8_TRIP(t, PG8_WAIT_VR, PG8_ST11, PG8_WAIT_V3) do { \
            const bool last = (t == nt - 2); \
            const char* a1 = cA + (size_t)(t + 1) * kstep;                                             \
            const char* a2 = last ? nA : cA + (size_t)(t + 2) * kstep; const char* b2 = last ? nB : cB + (size_t)(t + 2) * kstep;     \
            const char* a3 = a2 + kstep; const char* b3 = b2 + kstep;                                \
            unsigned s0[2], s1[2];                                                                 \
            if constexpr (GATHER) { s0[0] = last ? gN0[0] : gA0[0]; s0[1] = last ? gN0[1] : gA0[1]; s1[0] = last ? gN1[0] : gA1[0]; s1[1] = last ? gN1[1] : gA1[1]; } else { s0[0] = s1[0] = voffA[0]; s0[1] = s1[1] = voffA[1]; } \
            if (last && has_next) S.a_ready(nxt); \
            if constexpr (SP2) { \
              \
              \
            PG8_LDB(B0, 0, 0); PG8_LDB(B1, 0, 1); PG8_SCHED; PG8_LDA(At, 0, 0); PG8_ST11(a1); \
            PG8_WAIT_VR(); PG8_WAIT_L(0); PG8_BAR; PG8_MMA(0, 0, At, B0); PG8_MMA(0, 1, At, B1); PG8_BAR; PG8_SCHED; \
              \
            PG8_LDA(At, 0, 1); PG8_STAGEB(PG8_SB(0, 0), b2, voffB); PG8_STAGEB(PG8_SB(0, 1), b2 + hstep, voffB); PG8_STAGE(PG8_SA(0, 0), a2, s0); \
            PG8_WAIT_VR(); PG8_WAIT_L(0); PG8_BAR; PG8_MMA(1, 0, At, B0); PG8_MMA(1, 1, At, B1); PG8_BAR; PG8_SCHED; \
              \
            PG8_LDB(B0, 1, 0); PG8_LDB(B1, 1, 1); PG8_SCHED; PG8_LDA(At, 1, 0); PG8_STAGE(PG8_SA(0, 1), a2 + hstepA, s1); \
            PG8_WAIT_V3(); PG8_WAIT_L(0); PG8_BAR; PG8_MMA(0, 0, At, B0); PG8_MMA(0, 1, At, B1); PG8_BAR; PG8_SCHED; \
              \
            PG8_LDA(At, 1, 1); PG8_STAGEB(PG8_SB(1, 0), b3, voffB); PG8_STAGEB(PG8_SB(1, 1), b3 + hstep, voffB); PG8_STAGE(PG8_SA(1, 0), a3, s0); \
            PG8_WAIT_V(8); PG8_WAIT_L(0); PG8_BAR; PG8_MMA(1, 0, At, B0); PG8_MMA(1, 1, At, B1); PG8_BAR; PG8_SCHED; \
            } else { \
              \
            PG8_LDB(B0, 0, 0); PG8_SCHED; PG8_LDA(At, 0, 0); PG8_STAGE(PG8_SA(1, 1), a1 + hstepA, PG8_VA1); \
            PG8_WAIT_L(8); PG8_BAR; PG8_WAIT_L(0); PG8_MMA(0, 0, At, B0); PG8_BAR; PG8_SCHED; \
              \
            PG8_LDB(B1, 0, 1); PG8_STAGEB(PG8_SB(0, 0), b2, voffB); \
            PG8_BAR; PG8_WAIT_L(0); PG8_MMA(0, 1, At, B1); PG8_BAR; \
              \
            PG8_LDA(At, 0, 1); PG8_STAGE(PG8_SA(0, 0), a2, s0); \
            PG8_BAR; PG8_WAIT_L(0); PG8_MMA(1, 0, At, B0); PG8_BAR; PG8_SCHED; \
              \
            PG8_STAGEB(PG8_SB(0, 1), b2 + hstep, voffB); \
            PG8_WAIT_V(6); PG8_BAR; PG8_MMA(1, 1, At, B1); PG8_BAR; \
              \
            PG8_LDB(B0, 1, 0); PG8_SCHED; PG8_LDA(At, 1, 0); PG8_STAGE(PG8_SA(0, 1), a2 + hstepA, s1); \
            PG8_WAIT_L(8); PG8_BAR; PG8_WAIT_L(0); PG8_MMA(0, 0, At, B0); PG8_BAR; PG8_SCHED; \
              \
            PG8_LDB(B1, 1, 1); PG8_STAGEB(PG8_SB(1, 0), b3, voffB); \
            PG8_BAR; PG8_WAIT_L(0); PG8_MMA(0, 1, At, B1); PG8_BAR; \
              \
            PG8_LDA(At, 1, 1); PG8_STAGE(PG8_SA(1, 0), a3, s0); \
            PG8_BAR; PG8_WAIT_L(0); PG8_MMA(1, 0, At, B0); PG8_BAR; PG8_SCHED; \
              \
            PG8_STAGEB(PG8_SB(1, 1), b3 + hstep, voffB); \
            PG8_WAIT_V(6); PG8_BAR; PG8_MMA(1, 1, At, B1); PG8_BAR; \
            } \
        } while (0)
#define PG8_WV8() PG8_WAIT_V(8)
#define PG8_ST11_DO(a1_) PG8_STAGE(PG8_SA(1, 1), (a1_) + hstepA, PG8_VA1)
#define PG8_ST11_NONE(a1_) do { } while (0)
#define PG8_WV16() PG8_WAIT_V(16)
#define PG8_WV24() PG8_WAIT_V(24)
        { int t0_ = 0;
          if constexpr (SP2 && ALIGN_EPI && Epi::NST == 16) { if (ui > 0) { PG8_TRIP(0, PG8_WV24, PG8_ST11_NONE, PG8_WV24); t0_ = 2; } }
          if constexpr (SP2 && ALIGN_EPI && Epi::NST == 8 && F8 != 1) { if (ui > 0) { PG8_TRIP(0, PG8_WV16, PG8_ST11_NONE, PG8_WV16); t0_ = 2; } }
          _Pragma("nounroll") for (int t = t0_; t < nt; t += 2) PG8_TRIP(t, PG8_WV8, PG8_ST11_DO, PG8_WV8); }
#undef PG8_WV8
#undef PG8_WV16
#undef PG8_WV24
#undef PG8_TRIP
        if constexpr (ALIGN_EPI) { if (wr == 0) PG8_BAR; }
        if constexpr (SP2 && ALIGN_EPI && Epi::NST > 0 && F8 != 1) { if (has_next) PG8_STAGE(PG8_SA(1, 1), nA + kstep + hstepA, (GATHER ? gN1 : voffA)); }
        if constexpr (F8 == 2) asm volatile("s_nop 15\n\ts_nop 15\n\ts_nop 15" ::: "memory");
        if constexpr (!Epi::AFTER_DRAIN) { int le_; asm volatile("v_mbcnt_lo_u32_b32 %0, -1, 0\n\tv_mbcnt_hi_u32_b32 %0, -1, %0" : "=v"(le_));
            E(acc, cur, wr, wc, le_ & 15, le_ >> 4); S.done(cur); }
        if (!has_next) break;
#pragma unroll
        for (int a = 0; a < 2; ++a)
#pragma unroll
            for (int b = 0; b < 2; ++b)
#pragma unroll
                for (int m = 0; m < 4; ++m)
#pragma unroll
                    for (int n = 0; n < 2; ++n) acc[a][b][m][n] = (f32x4){0.f, 0.f, 0.f, 0.f};
        cur = nxt; cA = nA; cB = nB; ++ui;
        if constexpr (GATHER) { gA0[0] = gN0[0]; gA0[1] = gN0[1]; gA1[0] = gN1[0]; gA1[1] = gN1[1]; }
        if constexpr (ALIGN_EPI) { if (wr == 1) PG8_BAR; }
    }
    PG8_WAIT_V(0);
    if constexpr (!ALIGN_EPI) { if (wr == 0) PG8_BAR; }
    PG8_BAR;
    if constexpr (Epi::AFTER_DRAIN) { E.fused(acc, cur, wr, wc, fr, fq, lds, wid, lane); S.done(cur); }
#undef PG8_SA
#undef PG8_GLOAD
#undef PG8_VA0
#undef PG8_VA1
#undef PG8_SB
#undef PG8_STAGE
#undef PG8_STAGEB
#undef PG8_LDA
#undef PG8_LDB
#undef PG8_MMA
#undef PG8_WAIT_V
#undef PG8_WAIT_L
#undef PG8_BAR
#undef PG8_SCHED
}
}
#define GAS __attribute__((address_space(1)))
#define LAS __attribute__((address_space(3)))
typedef unsigned short bf16;
typedef unsigned v4u __attribute__((ext_vector_type(4)));
typedef float f32x4 __attribute__((ext_vector_type(4)));
typedef short bf16x8 __attribute__((ext_vector_type(8)));
typedef GAS unsigned gu32;
typedef GAS unsigned long long gu64;
#define RLX_AGENT __ATOMIC_RELAXED, __HIP_MEMORY_SCOPE_AGENT
#define LDS_WAIT() asm volatile("s_waitcnt lgkmcnt(0)" ::: "memory")
#define VM_WAIT() asm volatile("s_waitcnt vmcnt(0)" ::: "memory")
__device__ __forceinline__ unsigned long long rt() { return __builtin_amdgcn_s_memrealtime(); }
__device__ __forceinline__ unsigned f2bf(float f) { unsigned u = __builtin_bit_cast(unsigned, f); return (u + 0x7fffu + ((u >> 16) & 1u)) >> 16; }
__device__ __forceinline__ unsigned pk2(float lo, float hi) { return f2bf(lo) | (f2bf(hi) << 16); }
#define XB_TMO      128
#define XB_XCNT(j)  (256  + 64 * (j))
#define XB_XSUB(j)  (1280 + 64 * (j))
#define XB_XGEN(j)  (2304 + 64 * (j))
#define XB_TOP      3328
#define XB_TOPGEN   3392
#define XCD_BAR_WORDS 3456
#define XB_SPIN_CAP (1u << 18)

__device__ __forceinline__ unsigned xb_ld(unsigned* p)              { return __hip_atomic_load(p, __ATOMIC_RELAXED, __HIP_MEMORY_SCOPE_AGENT); }
__device__ __forceinline__ unsigned xb_add(unsigned* p, unsigned v) { return __hip_atomic_fetch_add(p, v, __ATOMIC_RELAXED, __HIP_MEMORY_SCOPE_AGENT); }
__device__ __forceinline__ unsigned xb_xcc_id() { return (unsigned)__builtin_amdgcn_s_getreg((3 << 11) | 20) & 0xFu; }
#define XB_SPIN(cond, bar) do { unsigned _sp = 0; while (cond) { __builtin_amdgcn_s_sleep(1); \
    if ((++_sp & 255u) == 0u) { if (xb_ld(&(bar)[XB_TMO])) break; if (_sp > XB_SPIN_CAP) { atomicAdd(&(bar)[XB_TMO], 1u); break; } } } } while (0)

struct XcdBarrier {
    unsigned* bar; unsigned x;
    volatile LAS unsigned* st;
    int w;
};

__device__ __forceinline__ XcdBarrier xcd_barrier_post(unsigned* bar, volatile LAS unsigned* st) {
    XcdBarrier b; b.bar = bar; b.x = xb_xcc_id(); b.st = st; b.w = __builtin_amdgcn_readfirstlane((int)threadIdx.x >> 6);
    if (threadIdx.x == 0) (void)xb_add(&bar[XB_XCNT(b.x)], 1u);
    return b;
}
__device__ __forceinline__ void xcd_barrier_complete(unsigned* bar, unsigned x, unsigned& nloc, unsigned& nx) {
    const unsigned G = gridDim.x * gridDim.y * gridDim.z;
    unsigned sum, cnt, mine, sp = 0u;
    for (;;) {
        sum = 0u; cnt = 0u; mine = 0u;
#pragma unroll
        for (unsigned j = 0; j < 16; ++j) { const unsigned c = xb_ld(&bar[XB_XCNT(j)]); sum += c; cnt += (c > 0u) ? 1u : 0u; mine = (j == x) ? c : mine; }
        if (sum == G) break;
        __builtin_amdgcn_s_sleep(1);
        if ((++sp & 255u) == 0u) { if (xb_ld(&bar[XB_TMO])) break; if (sp > XB_SPIN_CAP) { atomicAdd(&bar[XB_TMO], 1u); break; } }
    }
    nloc = mine > 0u ? mine : 1u; nx = cnt > 0u ? cnt : 1u;
}

__device__ __forceinline__ void xcd_barrier(const XcdBarrier& b) {
    asm volatile("s_waitcnt vmcnt(0)" ::: "memory");
    __syncthreads();
    int xl_; asm volatile("v_mbcnt_lo_u32_b32 %0, -1, 0\n\tv_mbcnt_hi_u32_b32 %0, -1, %0" : "=v"(xl_));
    if (b.w == 0 && xl_ == 0) {
        unsigned* bar = b.bar;
        __builtin_amdgcn_s_waitcnt(0);
        unsigned nloc = b.st[0], nx = b.st[1];
        if (nloc == 0u) { xcd_barrier_complete(bar, b.x, nloc, nx); b.st[0] = nloc; b.st[1] = nx; }
        const unsigned old = xb_add(&bar[XB_XSUB(b.x)], 1u);
        const unsigned gen = old / nloc;
        if (old + 1u == (gen + 1u) * nloc) {
            __builtin_amdgcn_fence(__ATOMIC_RELEASE, "agent");
            asm volatile("s_waitcnt vmcnt(0)" ::: "memory");
            const unsigned og = xb_add(&bar[XB_TOP], 1u);
            const unsigned tg = og / nx;
            if (og + 1u == (tg + 1u) * nx) xb_add(&bar[XB_TOPGEN], 1u);
            else XB_SPIN(xb_ld(&bar[XB_TOPGEN]) == tg, bar);
            __builtin_amdgcn_fence(__ATOMIC_ACQUIRE, "agent");
            xb_add(&bar[XB_XGEN(b.x)], 1u);
            asm volatile("s_waitcnt vmcnt(0)" ::: "memory");
        } else {
            XB_SPIN(xb_ld(&bar[XB_XGEN(b.x)]) == gen, bar);
            __builtin_amdgcn_fence(__ATOMIC_ACQUIRE, "agent");
            asm volatile("s_waitcnt vmcnt(0)" ::: "memory");
        }
    }
    __syncthreads();
}

constexpr int BATCH = 2, SEQ = 8192, D = 1024, DEPTH = 4, M = BATCH * SEQ;
constexpr int NHEAD = 8, NIN = 7168, NE = 16, FF = 2048, CAP = 1024, NSEL = BATCH * NE * CAP;
constexpr float NORM_EPS = 1e-6f;
constexpr float C2 = 0.125f * 1.4426950408889634f;

template <int MSK> __device__ __forceinline__ float xl_xor(float x) { static_assert(MSK < 32, "xl_xor: within 32 lanes"); return __int_as_float(__builtin_amdgcn_ds_swizzle(__float_as_int(x), (MSK << 10) | 0x1f)); }
__device__ __forceinline__ float xl_add32(float x) { auto rr = __builtin_amdgcn_permlane32_swap(__float_as_uint(x), __float_as_uint(x), false, false); return __uint_as_float(rr[0]) + __uint_as_float(rr[1]); }
__device__ __forceinline__ float xl_max32(float x) { auto rr = __builtin_amdgcn_permlane32_swap(__float_as_uint(x), __float_as_uint(x), false, false); return fmaxf(__uint_as_float(rr[0]), __uint_as_float(rr[1])); }
__device__ __forceinline__ unsigned xl_idx(unsigned v, int src_lane) { return (unsigned)__builtin_amdgcn_ds_bpermute(src_lane << 2, (int)v); }
namespace pg8 {
__device__ __forceinline__ float bf_lo(unsigned w) { return __builtin_bit_cast(float, w << 16); }
__device__ __forceinline__ float bf_hi(unsigned w) { return __builtin_bit_cast(float, w & 0xffff0000u); }
__device__ __forceinline__ float sigmoidf_(float x) { return __builtin_amdgcn_rcpf(1.0f + __builtin_amdgcn_exp2f(-1.4426950408889634f * x)); }

struct EpiIn {
    static constexpr bool PERM = true, AFTER_DRAIN = false; static constexpr int NST = 16;
    bf16_t* O; float* KN2; int roff; float wsc;
    template <int ACT> __device__ __forceinline__ void tile(const f32x4 (&acc)[2][2][4][2], bf16_t* base, int row0, int col0, float sc) const {
#pragma unroll
        for (int ai = 0; ai < 2; ++ai)
#pragma unroll
            for (int m = 0; m < 4; ++m) { bf16_t* rowp = base + (size_t)(row0 + ai * HALF + m * 16) * 1024 + col0;
#pragma unroll
                for (int bj = 0; bj < 2; ++bj) { f32x4 v0 = acc[ai][bj][m][0] * sc, v1 = acc[ai][bj][m][1] * sc;
                    if (ACT == 1) { f32x2 a = gelu_pk((f32x2){v0[0], v0[1]}), b = gelu_pk((f32x2){v0[2], v0[3]}), c = gelu_pk((f32x2){v1[0], v1[1]}), d = gelu_pk((f32x2){v1[2], v1[3]});
                        v0 = (f32x4){a.x, a.y, b.x, b.y}; v1 = (f32x4){c.x, c.y, d.x, d.y}; }
                    else if (ACT == 2) { v0 = (f32x4){sigmoidf_(v0[0]), sigmoidf_(v0[1]), sigmoidf_(v0[2]), sigmoidf_(v0[3])}; v1 = (f32x4){sigmoidf_(v1[0]), sigmoidf_(v1[1]), sigmoidf_(v1[2]), sigmoidf_(v1[3])}; }
                    u32x4 w; w.x = cvt_pk_bf16(v0[0], v0[1]); w.y = cvt_pk_bf16(v0[2], v0[3]); w.z = cvt_pk_bf16(v1[0], v1[1]); w.w = cvt_pk_bf16(v1[2], v1[3]);
                    *(u32x4*)(rowp + bj * HALF) = w; } }
    }
    __device__ __forceinline__ void operator()(const f32x4 (&acc)[2][2][4][2], const Unit& u, int wr, int wc, int fr, int fq) const {
        const int region = (u.pn >> 2) + roff, colt = (u.pn & 3) * BM;
        bf16_t* base = O + (size_t)region * ((size_t)M * 1024);
        const int row0 = u.pm * BM + wr * 64 + fr, col0 = colt + wc * 32 + 8 * fq;
        if (region < 3) { tile<0>(acc, base, row0, col0, region == 0 ? C2 : wsc);
        if (region == 1 && KN2 != nullptr) {
#pragma unroll
            for (int ai = 0; ai < 2; ++ai)
#pragma unroll
                for (int m = 0; m < 4; ++m)
#pragma unroll
                    for (int bj = 0; bj < 2; ++bj) { float ss = 0.f;
#pragma unroll
                        for (int n = 0; n < 2; ++n)
#pragma unroll
                            for (int q = 0; q < 4; ++q) { const float x = __builtin_bit_cast(float, (unsigned)(__builtin_bit_cast(unsigned, acc[ai][bj][m][n][q]) + 0x8000u) & 0xffff0000u); ss = __builtin_fmaf(x, x, ss); }
                        ss += xl_xor<16>(ss); ss = xl_add32(ss);
                        if (fq == 0) __hip_atomic_fetch_add(KN2 + (size_t)((colt + bj * HALF + wc * 32) >> 6) * M + (row0 + ai * HALF + m * 16), ss, __ATOMIC_RELAXED, __HIP_MEMORY_SCOPE_AGENT); }
        } }
        else if (region < 5) tile<1>(acc, base, row0, col0, wsc);
        else tile<2>(acc, base, row0, col0, wsc);
    }
};

template <bool ADD> struct EpiGate {
    static constexpr bool PERM = true, AFTER_DRAIN = false; static constexpr int NST = 0;
    const bf16_t* G; bf16_t* O;
    __device__ __forceinline__ void operator()(const f32x4 (&acc)[2][2][4][2], const Unit& u, int wr, int wc, int fr, int fq) const {
        const int row0 = u.pm * BM + wr * 64 + fr, col0 = u.pn * BM + wc * 32 + 8 * fq;
#pragma unroll
        for (int ai = 0; ai < 2; ++ai)
#pragma unroll
            for (int m = 0; m < 4; ++m) { const size_t off = (size_t)(row0 + ai * HALF + m * 16) * 1024 + col0;
#pragma unroll
                for (int bj = 0; bj < 2; ++bj) { const f32x4 v0 = acc[ai][bj][m][0], v1 = acc[ai][bj][m][1];
                    const u32x4 g = *(const u32x4*)(G + off + bj * HALF);
                    float r0 = v0[0] * bf_lo(g.x), r1 = v0[1] * bf_hi(g.x), r2 = v0[2] * bf_lo(g.y), r3 = v0[3] * bf_hi(g.y);
                    float r4 = v1[0] * bf_lo(g.z), r5 = v1[1] * bf_hi(g.z), r6 = v1[2] * bf_lo(g.w), r7 = v1[3] * bf_hi(g.w);
                    if (ADD) { const u32x4 p = *(const u32x4*)(O + off + bj * HALF);
                        r0 += bf_lo(p.x); r1 += bf_hi(p.x); r2 += bf_lo(p.y); r3 += bf_hi(p.y); r4 += bf_lo(p.z); r5 += bf_hi(p.z); r6 += bf_lo(p.w); r7 += bf_hi(p.w); }
                    u32x4 w; w.x = cvt_pk_bf16(r0, r1); w.y = cvt_pk_bf16(r2, r3); w.z = cvt_pk_bf16(r4, r5); w.w = cvt_pk_bf16(r6, r7);
                    *(u32x4*)(O + off + bj * HALF) = w; } }
    }
};

struct EpiGate2 {
    static constexpr bool PERM = true, AFTER_DRAIN = false; static constexpr int NST = 0;
    const bf16_t* G0; bf16_t* O;
    __device__ __forceinline__ void operator()(const f32x4 (&acc)[2][2][4][2], const Unit& u, int wr, int wc, int fr, int fq) const {
        const int which = u.pm >> 6; Unit v; v.pm = u.pm & 63; v.pn = u.pn & 3;
        if (which) { EpiGate<true> e{G0 + (size_t)M * 1024, O}; e(acc, v, wr, wc, fr, fq); } else { EpiGate<false> e{G0, O}; e(acc, v, wr, wc, fr, fq); }
    }
};
struct AbOrder { StaticOrder S;
    __device__ __forceinline__ bool next(int i, Unit& u) const { if (i >= 2) return false; if (!S.next(0, u)) return false; if (i == 1) { u.pm += 64; u.pn += 4; } return true; }
    __device__ __forceinline__ void a_ready(const Unit&) const {}
    __device__ __forceinline__ void done(const Unit&) const {}
};

struct EpiYb {
    static constexpr bool PERM = true, AFTER_DRAIN = false; static constexpr int NST = 0;
    bf16_t* O;
    __device__ __forceinline__ void operator()(const f32x4 (&acc)[2][2][4][2], const Unit& u, int wr, int wc, int fr, int fq) const {
        const EpiIn e{O, nullptr, 0, 1.0f}; e.template tile<0>(acc, O, u.pm * BM + wr * 64 + fr, u.pn * BM + wc * 32 + 8 * fq, 1.0f);
    }
};
struct EpiF32 {
    static constexpr bool PERM = false, AFTER_DRAIN = false; static constexpr int NST = 0;
    float* O;
    __device__ __forceinline__ void operator()(const f32x4 (&acc)[2][2][4][2], const Unit& u, int wr, int wc, int fr, int fq) const {
        const int row0 = u.pm * BM + wr * 64 + fr, col0 = u.pn * BM + wc * 32 + 4 * fq;
#pragma unroll
        for (int ai = 0; ai < 2; ++ai)
#pragma unroll
            for (int m = 0; m < 4; ++m) { float* rowp = O + (size_t)(row0 + ai * HALF + m * 16) * 1024 + col0;
#pragma unroll
                for (int bj = 0; bj < 2; ++bj)
#pragma unroll
                    for (int n = 0; n < 2; ++n) *(f32x4*)(rowp + bj * HALF + n * 16) = acc[ai][bj][m][n]; }
    }
};

__device__ __forceinline__ float f8clamp(float x) { return __builtin_fminf(__builtin_fmaxf(x, -448.0f), 448.0f); }
__device__ __forceinline__ unsigned pk4_fp8(float a, float b, float c, float d) {
    int w = 0; w = __builtin_amdgcn_cvt_pk_fp8_f32(f8clamp(a), f8clamp(b), w, false); w = __builtin_amdgcn_cvt_pk_fp8_f32(f8clamp(c), f8clamp(d), w, true); return (unsigned)w; }
struct EpiMoe1 {
    static constexpr bool PERM = true, AFTER_DRAIN = false; static constexpr int NST = 8;
    unsigned char* O; float wsc;
    __device__ __forceinline__ void operator()(const f32x4 (&acc)[2][2][4][2], const Unit& u, int wr, int wc, int fr, int fq) const {
        const int row0 = u.pm * BM + wr * 64 + fr, col0 = (u.pn & 15) * HALF + wc * 32 + 8 * fq;
#pragma unroll
        for (int ai = 0; ai < 2; ++ai)
#pragma unroll
            for (int m = 0; m < 4; ++m) { unsigned char* rowp = O + (size_t)(row0 + ai * HALF + m * 16) * FF + col0;
                float r[8];
#pragma unroll
                for (int n = 0; n < 2; ++n)
#pragma unroll
                    for (int q = 0; q < 4; ++q) { const float ag = acc[ai][0][m][n][q], au = acc[ai][1][m][n][q];
                        r[n * 4 + q] = (ag * au) * ((wsc * wsc) * __builtin_amdgcn_rcpf(1.0f + __builtin_amdgcn_exp2f(ag * (-1.4426950408889634f * wsc)))); }
                typedef unsigned u32x2_ __attribute__((ext_vector_type(2)));
                u32x2_ w; w.x = pk4_fp8(r[0], r[1], r[2], r[3]); w.y = pk4_fp8(r[4], r[5], r[6], r[7]);
                *(u32x2_*)rowp = w; }
    }
};

struct EpiMoe2 {
    static constexpr bool PERM = true, AFTER_DRAIN = false; static constexpr int NST = 0;
    bf16_t* O; const float* gate; float wsc;
    __device__ __forceinline__ void operator()(const f32x4 (&acc)[2][2][4][2], const Unit& u, int wr, int wc, int fr, int fq) const {
        const int row0 = u.pm * BM + wr * 64 + fr, col0 = (u.pn & 3) * BM + wc * 32 + 8 * fq;
#pragma unroll
        for (int ai = 0; ai < 2; ++ai)
#pragma unroll
            for (int m = 0; m < 4; ++m) { const int row = row0 + ai * HALF + m * 16; const float gt = gate[row] * wsc; bf16_t* rowp = O + (size_t)row * 1024 + col0;
#pragma unroll
                for (int bj = 0; bj < 2; ++bj) { const f32x4 v0 = acc[ai][bj][m][0] * gt, v1 = acc[ai][bj][m][1] * gt;
                    u32x4 w; w.x = cvt_pk_bf16(v0[0], v0[1]); w.y = cvt_pk_bf16(v0[2], v0[3]); w.z = cvt_pk_bf16(v1[0], v1[1]); w.w = cvt_pk_bf16(v1[2], v1[3]);
                    *(u32x4*)(rowp + bj * HALF) = w; } }
    }
};

struct MoeOrder1 {
    int vcu, G;
    __device__ __forceinline__ bool next(int i, Unit& u) const {
        if (G == 256) { if (i >= 8) return false; const int e = vcu >> 4, c = vcu & 15; u.pm = e * 8 + 4 * (i & 1) + (c & 3); u.pn = e * 16 + 4 * (i >> 1) + (c >> 2); return true; }
        const int id = i * G + vcu; if (id >= NE * 128) return false; const int e = id >> 7, r = id & 127; u.pm = e * 8 + (r & 7); u.pn = e * 16 + (r >> 3); return true;
    }
    __device__ __forceinline__ void a_ready(const Unit&) const {}
    __device__ __forceinline__ void done(const Unit&) const {}
};
struct MoeOrder2 {
    int vcu, G;
    __device__ __forceinline__ bool next(int i, Unit& u) const {
        if (G == 256) { if (i >= 2) return false; const int e = vcu >> 4, c = vcu & 15; u.pm = e * 8 + 4 * i + (c & 3); u.pn = e * 4 + (c >> 2); return true; }
        const int id = i * G + vcu; if (id >= NE * 32) return false; const int e = id >> 5, r = id & 31; u.pm = e * 8 + (r & 7); u.pn = e * 4 + (r >> 3); return true;
    }
    __device__ __forceinline__ void a_ready(const Unit&) const {}
    __device__ __forceinline__ void done(const Unit&) const {}
};
}

namespace att {
using bf16_t = unsigned short;
using bf16x8 = __attribute__((ext_vector_type(8))) short;
using s16x4  = __attribute__((ext_vector_type(4))) short;
using f32x16 = __attribute__((ext_vector_type(16))) float;
using f32x4  = __attribute__((ext_vector_type(4))) float;
using u32x4  = __attribute__((ext_vector_type(4))) unsigned;
constexpr int SHM_V = 64 * 128 * 2, SHM_K = 64 * 64 * 2, OFF_K = 2 * SHM_V, OFF_WS = OFF_K + 4 * SHM_K, OFF_KT = OFF_WS + 8 * 64 * 4, OFF_RED = OFF_KT + 128 * 4, LDS_BYTES = OFF_RED + 64;
constexpr float SKIP_T = 38.0f;
constexpr float DEAD_T = 38.0f;
constexpr float THR2 = 8.0f;
#define ATT_KSWZ(row, colB) ((row) * 128 + ((colB) ^ ((((row) >> 1) & 7) << 4)))
#define ATT_SBAR() __builtin_amdgcn_sched_barrier(0)
__device__ __forceinline__ int lane_id_asm() { int l; asm volatile("v_mbcnt_lo_u32_b32 %0, -1, 0\n\tv_mbcnt_hi_u32_b32 %0, -1, %0" : "=v"(l)); return l; }
__device__ __forceinline__ __amdgpu_buffer_rsrc_t att_rsrc(const void* p) {
  const unsigned long long v = (unsigned long long)p; const unsigned lo = __builtin_amdgcn_readfirstlane((unsigned)v), hi = __builtin_amdgcn_readfirstlane((unsigned)(v >> 32));
  return __builtin_amdgcn_make_buffer_rsrc((void*)(((unsigned long long)hi << 32) | lo), 0, 0x7ffffff0, 0x00020000); }
template <int MSK> __device__ __forceinline__ float swz_xor(float x) { return __int_as_float(__builtin_amdgcn_ds_swizzle(__float_as_int(x), (MSK << 10) | 0x1f)); }
template <int CTRL> __device__ __forceinline__ float dpp_mov(float x) { return __int_as_float(__builtin_amdgcn_update_dpp(0, __float_as_int(x), CTRL, 0xf, 0xf, true)); }
__device__ __forceinline__ float row16_sum(float v) { v += dpp_mov<0xB1>(v); v += dpp_mov<0x4E>(v); v += dpp_mov<0x141>(v); v += dpp_mov<0x140>(v); return v; }
__device__ __forceinline__ int crow(int r, int hi) { return (r & 3) + 8 * (r >> 2) + 4 * hi; }
typedef float f32x2a_t __attribute__((ext_vector_type(2))); typedef __bf16 bf16x2a_t __attribute__((ext_vector_type(2)));
__device__ __forceinline__ unsigned cvtpk(float lo, float hi) { f32x2a_t v = {lo, hi}; bf16x2a_t b = __builtin_convertvector(v, bf16x2a_t); return __builtin_bit_cast(unsigned, b); }

__device__ __forceinline__ int v_st(int k, int c) { const int kk = (k & ~0xC) | ((k & 4) << 1) | ((k & 8) >> 1); return ((kk >> 3) * 4 + (c >> 5)) * 512 + ((kk & 7) * 32 + (c & 31)) * 2; }
__device__ __forceinline__ int v_rd_base(int lane) { return ((lane & 3) << 3) | (((lane >> 2) & 3) << 6) | (((lane >> 4) & 1) << 5) | (((lane >> 5) & 1) << 8); }
constexpr int v_rd_off(int d0, int ks, int half) { return d0 * 512 + ks * 4096 + half * 2048; }
template <int OFF> __device__ __forceinline__ s16x4 tr_read(int vb) {
  s16x4 r; asm volatile("ds_read_b64_tr_b16 %0, %1 offset:%2" : "=&v"(r) : "v"(vb), "i"(OFF) : "memory"); return r;
}
template <int OFF> __device__ __forceinline__ bf16x8 k_read(int ka) {
  bf16x8 r; asm volatile("ds_read_b128 %0, %1 offset:%2" : "=&v"(r) : "v"(ka), "i"(OFF) : "memory"); return r;
}
template <int D0, int BOFF = 0> __device__ __forceinline__ void pv_one(f32x16& od, int vb, bf16x8 pa0, bf16x8 pa1, bf16x8 pa2, bf16x8 pa3) {
  const s16x4 l0 = tr_read<BOFF + v_rd_off(D0, 0, 0)>(vb), h0 = tr_read<BOFF + v_rd_off(D0, 0, 1)>(vb), l1 = tr_read<BOFF + v_rd_off(D0, 1, 0)>(vb), h1 = tr_read<BOFF + v_rd_off(D0, 1, 1)>(vb);
  const s16x4 l2 = tr_read<BOFF + v_rd_off(D0, 2, 0)>(vb), h2 = tr_read<BOFF + v_rd_off(D0, 2, 1)>(vb), l3 = tr_read<BOFF + v_rd_off(D0, 3, 0)>(vb), h3 = tr_read<BOFF + v_rd_off(D0, 3, 1)>(vb);
  asm volatile("s_waitcnt lgkmcnt(0)" ::: "memory"); ATT_SBAR();
#define ATT_PK(L, H) (bf16x8){L[0], L[1], L[2], L[3], H[0], H[1], H[2], H[3]}
  od = __builtin_amdgcn_mfma_f32_32x32x16_bf16(pa0, ATT_PK(l0, h0), od, 0, 0, 0);
  od = __builtin_amdgcn_mfma_f32_32x32x16_bf16(pa1, ATT_PK(l1, h1), od, 0, 0, 0);
  od = __builtin_amdgcn_mfma_f32_32x32x16_bf16(pa2, ATT_PK(l2, h2), od, 0, 0, 0);
  od = __builtin_amdgcn_mfma_f32_32x32x16_bf16(pa3, ATT_PK(l3, h3), od, 0, 0, 0);
#undef ATT_PK
}
template <int BOFF = 0> __device__ __forceinline__ void pv_d0(f32x16* o, int vb, bf16x8 pa0, bf16x8 pa1, bf16x8 pa2, bf16x8 pa3) {
  pv_one<0, BOFF>(o[0], vb, pa0, pa1, pa2, pa3); pv_one<1, BOFF>(o[1], vb, pa0, pa1, pa2, pa3); pv_one<2, BOFF>(o[2], vb, pa0, pa1, pa2, pa3); pv_one<3, BOFF>(o[3], vb, pa0, pa1, pa2, pa3);
}

template <int BOFF> __device__ __forceinline__ void qkt(f32x16& p0, f32x16& p1, const int (&ka4)[4], const bf16x8* qr, int r32, int hi, float dq, float nsl2, float negm, int side) {
  if (side == 0) {
#pragma unroll
    for (int r = 0; r < 16; ++r) { const float t0 = dq + (float)((r & 3) + 8 * (r >> 2)); p0[r] = __builtin_fmaf(nsl2, __builtin_fabsf(t0), negm); p1[r] = __builtin_fmaf(nsl2, __builtin_fabsf(t0 + 32.0f), negm); }
  } else {
    const float s = side < 0 ? -nsl2 : nsl2;
    const float b0 = __builtin_fmaf(s, dq, negm), b1 = __builtin_fmaf(s, 32.0f, b0);
#pragma unroll
    for (int r = 0; r < 16; ++r) { const float cr = (float)((r & 3) + 8 * (r >> 2)); p0[r] = __builtin_fmaf(s, cr, b0); p1[r] = __builtin_fmaf(s, cr, b1); }
  }
  bf16x8 kf[8];
  {
#pragma unroll
    for (int d0 = 0; d0 < 4; ++d0) { kf[2 * d0] = k_read<BOFF>(ka4[d0]); kf[2 * d0 + 1] = k_read<BOFF + 4096>(ka4[d0]); }
    asm volatile("s_waitcnt lgkmcnt(0)" ::: "memory"); ATT_SBAR(); }
#pragma unroll
  for (int d0 = 0; d0 < 4; ++d0) {
    p0 = __builtin_amdgcn_mfma_f32_32x32x16_bf16(kf[2 * d0], qr[d0], p0, 0, 0, 0);
    p1 = __builtin_amdgcn_mfma_f32_32x32x16_bf16(kf[2 * d0 + 1], qr[d0], p1, 0, 0, 0); }
}
template <bool FIRST> __device__ __forceinline__ bool partialSM(f32x16& p0, f32x16& p1, float& m_ref, float& alpha) {
  float pmax = p0[0];
#pragma unroll
  for (int r = 1; r < 16; ++r) pmax = fmaxf(pmax, p0[r]);
#pragma unroll
  for (int r = 0; r < 16; ++r) pmax = fmaxf(pmax, p1[r]);
  { auto rr = __builtin_amdgcn_permlane32_swap(__float_as_uint(pmax), __float_as_uint(pmax), false, false);
    pmax = fmaxf(__uint_as_float(rr[0]), __uint_as_float(rr[1])); }
  alpha = 1.f;
  if (!FIRST && __all(pmax < -DEAD_T)) return true;
  if (FIRST || !__all(pmax <= THR2)) {
    const float dl = FIRST ? pmax : fmaxf(pmax, 0.f);
    if (!FIRST) alpha = __builtin_amdgcn_exp2f(-dl);
    m_ref += dl;
#pragma unroll
    for (int r = 0; r < 16; ++r) { p0[r] -= dl; p1[r] -= dl; }
  }
#pragma unroll
  for (int r = 0; r < 16; ++r) p0[r] = __builtin_amdgcn_exp2f(p0[r]);
  return false;
}
__device__ __forceinline__ void finishSM(f32x16& p0, f32x16& p1, float alpha, float& l_reg, bf16x8& pa0, bf16x8& pa1, bf16x8& pa2, bf16x8& pa3) {
#pragma unroll
  for (int r = 0; r < 16; ++r) p1[r] = __builtin_amdgcn_exp2f(p1[r]);
  float ps = 0;
#pragma unroll
  for (int r = 0; r < 16; ++r) ps += p0[r];
#pragma unroll
  for (int r = 0; r < 16; ++r) ps += p1[r];
  { auto rr = __builtin_amdgcn_permlane32_swap(__float_as_uint(ps), __float_as_uint(ps), false, false);
    ps = __uint_as_float(rr[0]) + __uint_as_float(rr[1]); }
  l_reg = l_reg * alpha + ps;
#define ATT_PK4(P, BASE, OUT) do { unsigned a0 = cvtpk(P[BASE + 0], P[BASE + 1]), a1 = cvtpk(P[BASE + 2], P[BASE + 3]);   \
    unsigned b0 = cvtpk(P[BASE + 4], P[BASE + 5]), b1 = cvtpk(P[BASE + 6], P[BASE + 7]);                              \
    auto r0 = __builtin_amdgcn_permlane32_swap(a0, b0, false, false); auto r1 = __builtin_amdgcn_permlane32_swap(a1, b1, false, false); \
    u32x4 w = {r0[0], r1[0], r0[1], r1[1]}; OUT = *reinterpret_cast<bf16x8*>(&w); } while (0)
  ATT_PK4(p0, 0, pa0); ATT_PK4(p0, 8, pa1); ATT_PK4(p1, 0, pa2); ATT_PK4(p1, 8, pa3);
#undef ATT_PK4
}

__device__ __forceinline__ void attn_unit(int b, int h, int qb, const bf16_t* __restrict__ QB, const bf16_t* __restrict__ KB, const bf16_t* __restrict__ VB,
                                          bf16_t* __restrict__ OB, const float* __restrict__ KN2, float lam, float onemli, const float* __restrict__ gsub, char* lds, int wid) {
  const int lane = lane_id_asm(), tid = wid * 64 + lane, r32 = lane & 31, hi = lane >> 5;
  const int n = wid >> 2, wq = wid & 3;
  char* V_lds = lds; char* K_lds = lds + OFF_K;
  float* ws = (float*)(lds + OFF_WS) + wid * 64; float* li_l = ws; float* al_l = ws + 32;
  float* KT = (float*)(lds + OFF_KT); float* red = (float*)(lds + OFF_RED);
  const float nsl2 = -__builtin_amdgcn_exp2f(-(float)(h + 1)) * 1.4426950408889634f;
  const float sl2 = -nsl2;
  const int q0 = qb * 128, qp = q0 + wq * 32 + r32, jd = (q0 + wq * 32) >> 6;
  const size_t rowbase = (size_t)b * SEQ;
  const bf16_t* Vh = VB + rowbase * 1024 + h * 128;
  const bf16_t* Kh = KB + rowbase * 1024 + h * 64;
  const int kr = tid >> 3, kc = (tid & 7) * 8, sr = tid >> 4, sc = (tid & 15) * 8;
  const int kst = ATT_KSWZ(kr, kc * 2), vst0 = v_st(sr, sc), vst1 = v_st(32 + sr, sc);
  const int vb0 = (int)(uintptr_t)V_lds + v_rd_base(lane);
  const float dqn = (float)(4 * hi - qp);
  struct { bf16x8 vs0, vs1, k0, k1; } sr_[1];
  const __amdgpu_buffer_rsrc_t rsV_ = att_rsrc(Vh), rsK_ = att_rsrc(Kh);
  const int voV_ = (sr * 1024 + sc) * 2, voK_ = (kr * 1024 + kc) * 2;
#define ATT_SLOAD(i, kk0) do { const int so_ = (kk0) * 2048; \
    sr_[i].vs0 = __builtin_bit_cast(bf16x8, __builtin_amdgcn_raw_buffer_load_b128(rsV_, voV_, so_, 0)); sr_[i].vs1 = __builtin_bit_cast(bf16x8, __builtin_amdgcn_raw_buffer_load_b128(rsV_, voV_, so_ + 32 * 2048, 0)); \
    sr_[i].k0 = __builtin_bit_cast(bf16x8, __builtin_amdgcn_raw_buffer_load_b128(rsK_, voK_, so_, 0)); sr_[i].k1 = __builtin_bit_cast(bf16x8, __builtin_amdgcn_raw_buffer_load_b128(rsK_, voK_ + 1024, so_, 0)); } while (0)
#define ATT_SWRITE(bb, i) do { *(bf16x8*)(V_lds + (bb) * SHM_V + vst0) = sr_[i].vs0; *(bf16x8*)(V_lds + (bb) * SHM_V + vst1) = sr_[i].vs1; \
    *(bf16x8*)(K_lds + ((bb) * 2) * SHM_K + kst) = sr_[i].k0; *(bf16x8*)(K_lds + ((bb) * 2 + 1) * SHM_K + kst) = sr_[i].k1; } while (0)
#define ATT_SWAIT() asm volatile("s_waitcnt vmcnt(0)" ::: "memory")
  const int c0 = q0 >> 6;
  ATT_SLOAD(0, c0 * 64);
  bf16x8 qr[4];
  { const bf16_t* Qw = QB + (rowbase + qp) * 1024 + n * 512 + h * 64 + hi * 8;
#pragma unroll
    for (int d0 = 0; d0 < 4; ++d0) qr[d0] = *reinterpret_cast<const bf16x8*>(Qw + d0 * 16); }
  int jlo, NT; float qm_u;
  { f32x4 kna[4], knc[4];
    { const float* kn = KN2 + (size_t)h * M + rowbase + (tid >> 2) * 64 + (tid & 3) * 16;
#pragma unroll
      for (int i = 0; i < 4; ++i) { kna[i] = *reinterpret_cast<const f32x4*>(kn + 4 * i); knc[i] = *reinterpret_cast<const f32x4*>(kn + (size_t)8 * M + 4 * i); } }
    float qs = 0.f;
#pragma unroll
    for (int d0 = 0; d0 < 4; ++d0)
#pragma unroll
      for (int e = 0; e < 8; ++e) { const float x = __builtin_bit_cast(float, (unsigned)(unsigned short)qr[d0][e] << 16); qs = __builtin_fmaf(x, x, qs); }
    { auto rr = __builtin_amdgcn_permlane32_swap(__float_as_uint(qs), __float_as_uint(qs), false, false); qs = __uint_as_float(rr[0]) + __uint_as_float(rr[1]); }
    qs = fmaxf(qs, swz_xor<1>(qs)); qs = fmaxf(qs, swz_xor<2>(qs)); qs = fmaxf(qs, swz_xor<4>(qs)); qs = fmaxf(qs, swz_xor<8>(qs)); qs = fmaxf(qs, swz_xor<16>(qs));
    if (lane == 0) red[wid] = qs;
    ATT_SWRITE(0, 0); ATT_SLOAD(0, (c0 + 1) * 64);
    { const int tile = tid >> 2, part = tid & 3; float km = 0.f;
#pragma unroll
      for (int i = 0; i < 4; ++i) { const f32x4 a = kna[i], c = knc[i];
        km = fmaxf(fmaxf(km, fmaxf(fmaxf(a[0], a[1]), fmaxf(a[2], a[3]))), fmaxf(fmaxf(c[0], c[1]), fmaxf(c[2], c[3]))); }
      km = fmaxf(km, swz_xor<1>(km)); km = fmaxf(km, swz_xor<2>(km));
      if (part == 0) KT[tile] = __builtin_sqrtf(km); }
    __syncthreads();
    float qm = red[0];
#pragma unroll
    for (int w = 1; w < 8; ++w) qm = fmaxf(qm, red[w]);
    qm = __builtin_sqrtf(qm) * 1.002f; qm_u = qm;
    const int t2 = q0 >> 6; const float kself = fmaxf(KT[t2], KT[t2 + 1]);
    if (tid < 128) { const int j = tid; const int dmin = (64 * j + 63 < q0) ? (q0 - 64 * j - 63) : (64 * j > q0 + 127) ? (64 * j - q0 - 127) : 0;
      const bool need = (dmin == 0) || (qm * (KT[j] + kself) - sl2 * (float)dmin > -SKIP_T);
      const unsigned long long mk = __ballot(need);
      if (lane == 0) ((unsigned long long*)(red + 8))[wid] = mk; }
    __syncthreads();
    const unsigned long long m0 = ((const unsigned long long*)(red + 8))[0], m1 = ((const unsigned long long*)(red + 8))[1];
    int lo_ = m0 ? __builtin_ctzll(m0) : 64 + __builtin_ctzll(m1), hi_ = m1 ? 128 - __builtin_clzll(m1) : 64 - __builtin_clzll(m0);
    if ((hi_ - lo_) & 1) { if (hi_ < 128) ++hi_; else --lo_; }
    jlo = __builtin_amdgcn_readfirstlane(lo_); NT = __builtin_amdgcn_readfirstlane(hi_ - lo_); }
  float m_ref = 0.f, l_reg = 0.f; f32x16 o[4] = {};
#define ATT_RESC(a) do { if (__any((a) < 1.f)) { if (hi == 0) al_l[r32] = (a); asm volatile("s_waitcnt lgkmcnt(0)" ::: "memory"); \
    _Pragma("unroll") for (int d = 0; d < 4; ++d) _Pragma("unroll") for (int r = 0; r < 16; ++r) o[d][r] *= al_l[crow(r, hi)]; } } while (0)
  int nL = c0 - jlo;
#define ATT_TILE(s_) ((s_) < 2 ? c0 + (s_) : ((s_) - 2 < nL ? jlo + ((s_) - 2) : c0 + 2 + ((s_) - 2 - nL)))
#define ATT_SIDE(t) (ATT_TILE(t) < jd ? -1 : ATT_TILE(t) > jd ? 1 : 0)
  f32x16 pA0, pA1, pB0, pB1; float alA, alB; bf16x8 pa0, pa1, pa2, pa3;
  int ka4[4];
#pragma unroll
  for (int d0 = 0; d0 < 4; ++d0) ka4[d0] = (int)(uintptr_t)(K_lds + n * SHM_K) + ATT_KSWZ(r32, d0 * 32 + hi * 16);
  bool deadA = false, deadB = false;
  qkt<0>(pA0, pA1, ka4, qr, r32, hi, dqn + (float)(ATT_TILE(0) * 64), nsl2, 0.f, ATT_SIDE(0)); (void)partialSM<true>(pA0, pA1, m_ref, alA);
  { float mm = m_ref; mm = fminf(mm, swz_xor<1>(mm)); mm = fminf(mm, swz_xor<2>(mm)); mm = fminf(mm, swz_xor<4>(mm)); mm = fminf(mm, swz_xor<8>(mm)); mm = fminf(mm, swz_xor<16>(mm));
    if (lane == 0) red[wid] = mm;
    __syncthreads();
    float mmin = red[0];
#pragma unroll
    for (int w = 1; w < 8; ++w) mmin = fminf(mmin, red[w]);
    if (tid < 128) { const int j = tid; const int dmin = (64 * j + 63 < q0) ? (q0 - 64 * j - 63) : (64 * j > q0 + 127) ? (64 * j - q0 - 127) : 0;
      const bool need = (j >= jlo) && (j < jlo + NT) && ((dmin == 0) || (qm_u * KT[j] - sl2 * (float)dmin - mmin > -SKIP_T));
      const unsigned long long mk = __ballot(need);
      if (lane == 0) ((unsigned long long*)(red + 8))[wid] = mk; }
    __syncthreads();
    const unsigned long long m0 = ((const unsigned long long*)(red + 8))[0], m1 = ((const unsigned long long*)(red + 8))[1];
    int lo_ = m0 ? __builtin_ctzll(m0) : 64 + __builtin_ctzll(m1), hi_ = m1 ? 128 - __builtin_clzll(m1) : 64 - __builtin_clzll(m0);
    if ((hi_ - lo_) & 1) { if (hi_ < 128) ++hi_; else --lo_; }
    jlo = __builtin_amdgcn_readfirstlane(lo_); NT = __builtin_amdgcn_readfirstlane(hi_ - lo_);
    nL = c0 - jlo; }
  ATT_SWAIT(); ATT_SWRITE(1, 0); __syncthreads();
#pragma nounroll
  for (int j = 1; j + 1 < NT; j += 2) {
    const int tj = ATT_TILE(j), tj1 = ATT_TILE(j + 1), tj2 = ATT_TILE(j + 2);
    ATT_SBAR(); qkt<2 * SHM_K>(pB0, pB1, ka4, qr, r32, hi, dqn + (float)(tj * 64), nsl2, -m_ref, tj < jd ? -1 : tj > jd ? 1 : 0);
    if (!deadA) finishSM(pA0, pA1, alA, l_reg, pa0, pa1, pa2, pa3); ATT_SBAR();
    ATT_SLOAD(0, tj1 * 64); ATT_SBAR();
    if (!deadA) pv_d0(o, vb0, pa0, pa1, pa2, pa3); deadB = partialSM<false>(pB0, pB1, m_ref, alB);
    __syncthreads(); ATT_SWAIT(); ATT_SWRITE(0, 0);
    ATT_RESC(alB); __syncthreads();
    ATT_SBAR(); qkt<0>(pA0, pA1, ka4, qr, r32, hi, dqn + (float)(tj1 * 64), nsl2, -m_ref, tj1 < jd ? -1 : tj1 > jd ? 1 : 0);
    if (!deadB) finishSM(pB0, pB1, alB, l_reg, pa0, pa1, pa2, pa3); ATT_SBAR();
    ATT_SLOAD(0, tj2 * 64); ATT_SBAR();
    if (!deadB) pv_d0<SHM_V>(o, vb0, pa0, pa1, pa2, pa3); deadA = partialSM<false>(pA0, pA1, m_ref, alA);
    __syncthreads(); ATT_SWAIT(); ATT_SWRITE(1, 0);
    ATT_RESC(alA); __syncthreads();
  }
  { const int tl = ATT_TILE(NT - 1);
    ATT_SBAR(); qkt<2 * SHM_K>(pB0, pB1, ka4, qr, r32, hi, dqn + (float)(tl * 64), nsl2, -m_ref, tl < jd ? -1 : tl > jd ? 1 : 0); }
  if (!deadA) finishSM(pA0, pA1, alA, l_reg, pa0, pa1, pa2, pa3); ATT_SBAR();
  if (!deadA) pv_d0(o, vb0, pa0, pa1, pa2, pa3); deadB = partialSM<false>(pB0, pB1, m_ref, alB);
  __syncthreads(); ATT_RESC(alB);
  if (!deadB) { finishSM(pB0, pB1, alB, l_reg, pa0, pa1, pa2, pa3); ATT_SBAR();
    pv_d0<SHM_V>(o, vb0, pa0, pa1, pa2, pa3); }
  if (hi == 0) li_l[r32] = l_reg; asm volatile("s_waitcnt lgkmcnt(0)" ::: "memory");
  float rli[16];
#pragma unroll
  for (int r = 0; r < 16; ++r) rli[r] = __builtin_amdgcn_rcpf(li_l[crow(r, hi)]);
  __syncthreads();
  float* xch = (float*)lds + wq * 4096 + lane;
#define ATT_XW(R0) do { _Pragma("unroll") for (int r = (R0); r < (R0) + 8; ++r) _Pragma("unroll") for (int d0 = 0; d0 < 4; ++d0) xch[(d0 * 16 + r) * 64] = o[d0][r] * rli[r]; } while (0)
  if (n == 1) ATT_XW(0); else ATT_XW(8);
#undef ATT_XW
  __syncthreads();
  { int hi_e = hi, r32_e = r32; asm volatile("" : "+v"(hi_e), "+v"(r32_e));
    const unsigned lo_e = (unsigned)(hi_e * 4096 + r32_e);
    bf16_t* const obw = OB + (rowbase + q0 + wq * 32) * 1024 + h * 128;
    float gs[4];
#pragma unroll
    for (int d0 = 0; d0 < 4; ++d0) gs[d0] = gsub[d0 * 32 + r32_e] * onemli;
#define ATT_FIN(R0, MINE_IS_1) do { _Pragma("unroll") for (int r = (R0); r < (R0) + 8; ++r) { const unsigned off = lo_e + (unsigned)(((r & 3) + 8 * (r >> 2)) * 1024); float dv[4]; float ss = 0.f; \
      _Pragma("unroll") for (int d0 = 0; d0 < 4; ++d0) { const float mine = o[d0][r] * rli[r], oth = xch[(d0 * 16 + r) * 64]; dv[d0] = (MINE_IS_1) ? mine - lam * oth : oth - lam * mine; ss += dv[d0] * dv[d0]; } \
      ss = row16_sum(ss); ss += swz_xor<16>(ss); \
      const float rs = __builtin_amdgcn_rsqf(ss * (1.0f / 128.0f) + NORM_EPS); \
      _Pragma("unroll") for (int d0 = 0; d0 < 4; ++d0) obw[off + d0 * 32] = (bf16_t)f2bf(dv[d0] * rs * gs[d0]); \
      if ((r & 3) == 3) asm volatile("" ::: "memory"); } } while (0)
    if (n == 0) ATT_FIN(0, true); else ATT_FIN(8, false);
#undef ATT_FIN
  }
  __syncthreads();
#undef ATT_SLOAD
#undef ATT_SIDE
#undef ATT_TILE
#undef ATT_SWRITE
#undef ATT_SWAIT
#undef ATT_RESC
}
}

constexpr size_t MiB = 1u << 20;
constexpr size_t WS_CTL = 0, CTL_ZERO_BYTES = 1 * MiB;
constexpr size_t WS_MOD = 1 * MiB;
constexpr size_t WS_WSP = 2 * MiB;
constexpr size_t WS_AFF = 3 * MiB;
constexpr size_t WS_SLOT = 4 * MiB;
constexpr size_t WS_IDX = 5 * MiB;
constexpr size_t WS_KN2 = 6 * MiB;
constexpr size_t WS_W = 8 * MiB, W_LAYER = 212 * MiB;
constexpr size_t W_IN = 0, W_A = 14 * MiB, W_B = 16 * MiB, W_O = 18 * MiB, W_GU = 20 * MiB, W_D = 148 * MiB;
constexpr size_t WS_XN = WS_W + DEPTH * W_LAYER;
constexpr size_t WS_Z = WS_XN + 32 * MiB;
constexpr size_t WS_OB = WS_Z + 224 * MiB, WS_SG = WS_OB + 32 * MiB, WS_MRG = WS_SG + 32 * MiB;
constexpr size_t WS_Y = WS_MRG + 32 * MiB;
constexpr size_t WS_H2 = WS_Y + 64 * MiB;
constexpr size_t WS_XG = WS_H2 + 32 * MiB;
constexpr size_t WS_HID = WS_XG + 64 * MiB;
constexpr size_t WS_YC = WS_HID + 128 * MiB;
constexpr size_t WS_O1 = WS_YC + 64 * MiB;
constexpr size_t WS_END = WS_O1 + 64 * MiB;
constexpr int CW_BAR = 4096, CW_QUEUE = 8192;
constexpr int RING_BYTES = 131072, LDSCTL_OFF = RING_BYTES, MISC_OFF = LDSCTL_OFF + 320, LDS_BYTES = 147456;
constexpr int NWAVES = 8;
constexpr int NPHASE = 2 + 10 * DEPTH;

typedef float f32x4g __attribute__((ext_vector_type(4)));
typedef unsigned u32x2 __attribute__((ext_vector_type(2)));

__device__ __forceinline__ float wave_sum(float v) {
    v = att::row16_sum(v); v += att::swz_xor<16>(v);
    auto rr = __builtin_amdgcn_permlane32_swap(__float_as_uint(v), __float_as_uint(v), false, false);
    return __uint_as_float(rr[0]) + __uint_as_float(rr[1]);
}
__device__ __forceinline__ float bflo(unsigned w) { return __builtin_bit_cast(float, w << 16); }
__device__ __forceinline__ float bfhi(unsigned w) { return __builtin_bit_cast(float, w & 0xffff0000u); }

__device__ __forceinline__ void tr_item(const float* W, int K, int N, bf16* WT, int k0, int n0, int drow0, LAS float* scr, int lane) {
#pragma unroll 8
    for (int i = 0; i < 32; ++i) { const int kk = 2 * i + (lane >> 5); scr[kk * 33 + (lane & 31)] = __builtin_nontemporal_load(W + (size_t)(k0 + kk) * N + n0 + (lane & 31)); }
    LDS_WAIT(); asm volatile("" ::: "memory");
    const int c = lane & 7;
#pragma unroll
    for (int j = 0; j < 4; ++j) { const int n = (lane >> 3) + 8 * j; const LAS float* s = scr + (8 * c) * 33 + n;
        v4u o; o.x = pk2(s[0 * 33], s[1 * 33]); o.y = pk2(s[2 * 33], s[3 * 33]); o.z = pk2(s[4 * 33], s[5 * 33]); o.w = pk2(s[6 * 33], s[7 * 33]);
        __builtin_nontemporal_store(o, (GAS v4u*)(WT + (size_t)(drow0 + n) * K + k0 + 8 * c)); }
    LDS_WAIT(); asm volatile("" ::: "memory");
}

constexpr float W8_SCALE = 128.0f; constexpr int W8_E8M0 = 2;
__device__ __forceinline__ void tr_item8(const float* W, int K, int N, unsigned char* WT, int k0, int n0, int drow0, LAS float* scr, int lane) {
#pragma unroll 8
    for (int i = 0; i < 32; ++i) { const int kk = 2 * i + (lane >> 5); scr[kk * 33 + (lane & 31)] = __builtin_nontemporal_load(W + (size_t)(k0 + kk) * N + n0 + (lane & 31)); }
    LDS_WAIT(); asm volatile("" ::: "memory");
    const int c = lane & 7;
#pragma unroll
    for (int j = 0; j < 4; ++j) { const int n = (lane >> 3) + 8 * j; const LAS float* s = scr + (8 * c) * 33 + n;
        u32x2 o; o.x = pg8::pk4_fp8(s[0 * 33] * W8_SCALE, s[1 * 33] * W8_SCALE, s[2 * 33] * W8_SCALE, s[3 * 33] * W8_SCALE); o.y = pg8::pk4_fp8(s[4 * 33] * W8_SCALE, s[5 * 33] * W8_SCALE, s[6 * 33] * W8_SCALE, s[7 * 33] * W8_SCALE);
        __builtin_nontemporal_store(o, (GAS u32x2*)(WT + (size_t)(drow0 + n) * K + k0 + 8 * c)); }
    LDS_WAIT(); asm volatile("" ::: "memory");
}

__device__ __forceinline__ void modulate_store(const f32x4g (&v)[4], float rstd, const float* g, const float* sh, const float* sc, bf16* orow, unsigned char* orow8, int lane) {
#pragma unroll
    for (int j = 0; j < 4; ++j) { const int col = 4 * lane + 256 * j;
        const f32x4g gv = *(const f32x4g*)(g + col), sv = *(const f32x4g*)(sh + col), cv = *(const f32x4g*)(sc + col);
        const f32x4g h = v[j] * rstd * gv * (cv + 1.0f) + sv;
        u32x2 w; w.x = pk2(h.x, h.y); w.y = pk2(h.z, h.w); *(u32x2*)(orow + col) = w;
        *(unsigned*)(orow8 + col) = pg8::pk4_fp8(h.x, h.y, h.z, h.w); }
}

#ifndef PH_EN
#define PH_EN(k) 1
#endif
#ifndef MK_DUP_KIND
#define MK_DUP_KIND (-1)
#endif
#define DUPN(k) (((k) == MK_DUP_KIND || ((k) == 3 && (MK_DUP_KIND >= 12 && MK_DUP_KIND <= 17))) ? 2 : 1)
#ifndef MK_SINGLE
#define MK_SINGLE 1
#endif
struct Args { const float* in[26]; float* out; unsigned char* ws; int ph_lo, ph_hi, single, pad; };

__global__ void __launch_bounds__(NWAVES * 64, 2) mk_fwd(Args args) {
    extern __shared__ __attribute__((aligned(16))) unsigned char lds[];
    LAS unsigned char* const ldsl = (LAS unsigned char*)lds;
    volatile LAS unsigned* const MISC = (volatile LAS unsigned*)(ldsl + MISC_OFF);
    constexpr int G = 256; const int bx = blockIdx.x; const int vcu = (bx & 7) * (G / 8) + (bx >> 3);
    const int NGW = G * NWAVES;
    const int wave = __builtin_amdgcn_readfirstlane((int)threadIdx.x >> 6);
    unsigned char* ws_raw = args.ws;
    GAS unsigned char* ws = (GAS unsigned char*)ws_raw;
    gu32* const ctl = (gu32*)(ws + WS_CTL);
    for (int u = threadIdx.x; u < (LDS_BYTES - LDSCTL_OFF) / 4; u += NWAVES * 64) ((LAS unsigned*)(ldsl + LDSCTL_OFF))[u] = 0u;
    __syncthreads();
    XcdBarrier bar; bar.bar = (unsigned*)(ctl + CW_BAR); bar.x = 0; bar.st = nullptr; bar.w = wave;
#if MK_SINGLE
    bar = xcd_barrier_post((unsigned*)(ctl + CW_BAR), MISC + 8);
#else
    const int lo = args.ph_lo, hi = args.ph_hi;
#endif
#if MK_SINGLE
#define IN(k) true
#else
#define IN(k) (lo <= (k) && (k) < hi)
#endif
#define PHASE_ENV() int l_op_ = l; unsigned char* ws_op_ = args.ws; asm volatile("" : "+s"(l_op_), "+s"(ws_op_)); const int l = l_op_; GAS unsigned char* const ws = (GAS unsigned char*)ws_op_; \
    GAS unsigned char* const wl = ws + WS_W + (size_t)l * W_LAYER; const float* const md0 = MOD + (size_t)l * BATCH * 6144; (void)wl; (void)md0
#define PHASE_IDS() int lane_p; asm volatile("v_mbcnt_lo_u32_b32 %0, -1, 0\n\tv_mbcnt_hi_u32_b32 %0, -1, %0" : "=v"(lane_p)); const int lane = lane_p, tid = wave * 64 + lane, gw = vcu * NWAVES + wave; (void)tid; (void)gw
#if MK_SINGLE
#define SEAM(k) do { if ((k) + 1 < NPHASE) { XcdBarrier b_ = bar; unsigned z_ = 0u; asm volatile("" : "+s"(z_), "+s"(b_.x)); b_.bar = bar.bar + z_; xcd_barrier(b_); } } while (0)
#else
#define SEAM(k) do { } while (0)
#endif

#define MOD ((float*)(GAS float*)(ws + WS_MOD))
#define LAMV ((float*)(GAS float*)(ws + WS_MOD + 256 * 1024))
#define WSPB ((bf16*)(GAS bf16*)(ws + WS_WSP))
#define AFF ((float*)(GAS float*)(ws + WS_AFF))
#define SLOTMAP ((int*)(GAS int*)(ws + WS_SLOT))
#define IDX ((int*)(GAS int*)(ws + WS_IDX))
#define GATEV ((float*)(GAS float*)(ws + WS_IDX + 512 * 1024))
#define KN2 ((float*)(GAS float*)(ws + WS_KN2))
#define XN ((bf16*)(GAS bf16*)(ws + WS_XN))
#define ZB ((bf16*)(GAS bf16*)(ws + WS_Z))
#define QB ZB
#define KB (ZB + (size_t)M * 1024)
#define VB (ZB + 2 * (size_t)M * 1024)
#define UB (ZB + 3 * (size_t)M * 1024)
#define VGB (ZB + 4 * (size_t)M * 1024)
#define GAB (ZB + 5 * (size_t)M * 1024)
#define GBB (ZB + 6 * (size_t)M * 1024)
#define OB ((bf16*)(GAS bf16*)(ws + WS_OB))
#define SGB ((bf16*)(GAS bf16*)(ws + WS_SG))
#define MRG ((bf16*)(GAS bf16*)(ws + WS_MRG))
#define Y ((bf16*)(GAS bf16*)(ws + WS_Y))
#define H2 ((bf16*)(GAS bf16*)(ws + WS_H2))
#define XG ((bf16*)(GAS bf16*)(ws + WS_XG))
#define XN8 ((unsigned char*)(GAS unsigned char*)(ws + WS_XG + 32 * MiB))
#define HID ((bf16*)(GAS bf16*)(ws + WS_HID))
#define YC ((bf16*)(GAS bf16*)(ws + WS_YC))
#define O1S ((float*)(GAS float*)(ws + WS_O1))
#define XOUT (args.out)
#define XR ((bf16*)(GAS bf16*)(ws + WS_XG))

    if (PH_EN(0) && IN(0)) for (int rep_ = 0; rep_ < DUPN(0); ++rep_) { PHASE_IDS();
        { LAS float* cact = (LAS float*)ldsl; LAS float* part = cact + 2048;
          const float* c = args.in[1];
          for (int i = tid; i < 2048; i += 512) { const float x = c[i]; cact[i] = x / (1.0f + __expf(-x)); }
          __syncthreads();
          for (int it = vcu; it < DEPTH * 96; it += G) {
              const int l = it / 96, cb = it % 96, col = cb * 64 + lane;
              const float* wp = args.in[2] + (size_t)l * 1024 * 6144 + (size_t)(wave * 128) * 6144 + col;
              float a0 = 0.f, a1 = 0.f;
#pragma unroll 8
              for (int k = 0; k < 128; ++k) { const float w = wp[(size_t)k * 6144]; a0 += cact[wave * 128 + k] * w; a1 += cact[1024 + wave * 128 + k] * w; }
              part[(wave * 2 + 0) * 64 + lane] = a0; part[(wave * 2 + 1) * 64 + lane] = a1;
              __syncthreads();
              if (wave < 2) { float s = 0.f;
#pragma unroll
                  for (int w8 = 0; w8 < 8; ++w8) s += part[(w8 * 2 + wave) * 64 + lane];
                  MOD[((size_t)l * BATCH + wave) * 6144 + col] = s + args.in[3][(size_t)l * 6144 + col]; }
              __syncthreads();
          }
          if (bx == 0 && tid < DEPTH) { const int l = tid; float d1 = 0.f, d2 = 0.f;
              for (int i = 0; i < 64; ++i) { d1 += args.in[7][l * 64 + i] * args.in[8][l * 64 + i]; d2 += args.in[9][l * 64 + i] * args.in[10][l * 64 + i]; }
              const float li = 0.8f - 0.6f * __expf(-0.3f * (float)l);
              LAMV[2 * l] = __expf(d1) - __expf(d2) + li; LAMV[2 * l + 1] = 1.0f - li; }
          __syncthreads();
        }
        { const float* wsp = args.in[14]; const int n8 = DEPTH * 8 * 128 * 128 / 8;
          for (int i = gw * 64 + lane; i < n8; i += NGW * 64) { const f32x4g a = *(const f32x4g*)(wsp + (size_t)i * 8), b = *(const f32x4g*)(wsp + (size_t)i * 8 + 4);
              v4u o; o.x = pk2(a.x, a.y); o.y = pk2(a.z, a.w); o.z = pk2(b.x, b.y); o.w = pk2(b.z, b.w); *(v4u*)(WSPB + (size_t)i * 8) = o; } }
        { LAS float* scr = (LAS float*)(ldsl + wave * 16384);
          constexpr int I_IN = 16 * 224, I_SQ = 16 * 32, I_GU = 16 * 64, I_DN = 32 * 32;
          constexpr int PER_LAYER = I_IN + 3 * I_SQ + 2 * NE * I_GU + NE * I_DN;
          for (int it = gw; it < DEPTH * PER_LAYER; it += NGW) {
              const int l = it / PER_LAYER; int r = it % PER_LAYER;
              GAS unsigned char* wl = ws + WS_W + (size_t)l * W_LAYER;
              if (r < I_IN) { const int kb = r / 224, nb = r % 224;
                  if (nb < 64) tr_item(args.in[6] + (size_t)l * 1024 * NIN, 1024, NIN, (bf16*)(GAS bf16*)(wl + W_IN), kb * 64, nb * 32, nb * 32, scr, lane);
                  else tr_item8(args.in[6] + (size_t)l * 1024 * NIN, 1024, NIN, (unsigned char*)(GAS unsigned char*)(wl + W_IN + 4 * MiB), kb * 64, nb * 32, nb * 32 - 2048, scr, lane);
                  continue; } r -= I_IN;
              if (r < 3 * I_SQ) { const int w = r / I_SQ, q = r % I_SQ, kb = q / 32, nb = q % 32;
                  tr_item(args.in[16 + w] + (size_t)l * 1024 * 1024, 1024, 1024, (bf16*)(GAS bf16*)(wl + (w == 0 ? W_A : w == 1 ? W_B : W_O)), kb * 64, nb * 32, nb * 32, scr, lane); continue; } r -= 3 * I_SQ;
              if (r < 2 * NE * I_GU) { const int up = r / (NE * I_GU), q = r % (NE * I_GU), e = q / I_GU, q2 = q % I_GU, kb = q2 / 64, nb = q2 % 64, n0 = nb * 32;
                  tr_item8(args.in[23 + up] + ((size_t)l * NE + e) * 1024 * FF, 1024, FF, (unsigned char*)(GAS unsigned char*)(wl + W_GU), kb * 64, n0, e * 4096 + 256 * (n0 >> 7) + (n0 & 127) + up * 128, scr, lane); continue; } r -= 2 * NE * I_GU;
              { const int e = r / I_DN, q = r % I_DN, kb = q / 32, nb = q % 32;
                  tr_item8(args.in[25] + ((size_t)l * NE + e) * FF * 1024, FF, 1024, (unsigned char*)(GAS unsigned char*)(wl + W_D), kb * 64, nb * 32, e * 1024 + nb * 32, scr, lane); }
          } }
        SEAM(0);
    }
    if (PH_EN(1) && IN(1)) { PHASE_IDS();
        for (int m = gw; m < M; m += NGW) { const int b = m / SEQ;
            const f32x4g* xr = (const f32x4g*)(args.in[0] + (size_t)m * D) + lane; f32x4g v[4]; float s = 0.f;
#pragma unroll
            for (int j = 0; j < 4; ++j) { v[j] = xr[64 * j]; s += (v[j].x * v[j].x + v[j].y * v[j].y) + (v[j].z * v[j].z + v[j].w * v[j].w); }
            const float rstd = __builtin_amdgcn_rsqf(wave_sum(s) * (1.f / D) + NORM_EPS);
            const float* md = MOD + (size_t)b * 6144;
            modulate_store(v, rstd, args.in[4], md + 0, md + 1024, XN + (size_t)m * D, XN8 + (size_t)m * D, lane);
#pragma unroll
            for (int j = 0; j < 4; ++j) { u32x2 w; w.x = pk2(v[j].x, v[j].y); w.y = pk2(v[j].z, v[j].w); *(u32x2*)(XR + (size_t)m * D + 4 * lane + 256 * j) = w; }
            }
        if (gw * 128 < M * 16) { unsigned z_ = 0u; asm volatile("" : "+v"(z_)); *(u32x2*)(KN2 + gw * 128 + 2 * lane) = (u32x2){z_, z_}; }
        SEAM(1);
    }

#pragma nounroll
    for (int l = 0; l < DEPTH; ++l) {
        const int pb = 2 + 10 * l;
#if !MK_SINGLE
        if (pb >= hi) break;
#endif
        if (PH_EN(2) && IN(pb + 0)) for (int rep_ = 0; rep_ < DUPN(2); ++rep_) { PHASE_ENV();
            { pg8::Gemm g{XN, (const bf16*)(GAS bf16*)(wl + W_IN), M, 2048, D}; pg8::StaticOrder S; S.init(M, 2048, G, bx);
              pg8::EpiIn E{ZB, (DUPN(2) == 2 && rep_ == 0) ? (float*)nullptr : KN2, 0, 1.0f};
              pg8::gemm_phase<pg8::EpiIn, pg8::StaticOrder, true, true>(ldsl, g, S, E, wave); }
            { pg8::Gemm g{(const bf16*)XN8, (const bf16*)(GAS bf16*)(wl + W_IN + 4 * MiB), M, NIN - 2048, D / 2}; pg8::StaticOrder S; S.init(M, NIN - 2048, G, bx);
              pg8::EpiIn E{ZB, (float*)nullptr, 2, 1.0f / W8_SCALE};
              pg8::gemm_phase<pg8::EpiIn, pg8::StaticOrder, true, true, false, 0, W8_E8M0>(ldsl, g, S, E, wave); }
            SEAM(pb + 0);
        }
        if (PH_EN(3) && IN(pb + 1)) for (int rep_ = 0; rep_ < DUPN(3); ++rep_) { PHASE_ENV(); PHASE_IDS();
            const float lam = LAMV[2 * l], onemli = LAMV[2 * l + 1];
            const int xme = (int)(xb_xcc_id() & 7u);
            for (int kq = 0; kq < 8; ++kq) { const int xq = (xme + kq) & 7;
            for (;;) {
                if (tid == 0) MISC[16] = __hip_atomic_fetch_add((unsigned*)(ctl + CW_QUEUE + 64 * (l * 8 + xq + 32 * rep_)), 1u, __ATOMIC_RELAXED, __HIP_MEMORY_SCOPE_AGENT);
                __syncthreads(); const int uq = (int)MISC[16]; __syncthreads();
                if (uq >= 160) break;
                if (uq < 128) { if (PH_EN(12) && !(MK_DUP_KIND == 13 && rep_ == 1) && !(MK_DUP_KIND >= 14 && rep_ == 1 && (uq >> 5) != MK_DUP_KIND - 14)) {        const int c_ = xq & 3, k_ = uq >> 5, b = c_ >> 1, qb = (c_ & 1) * 32 + (uq & 31), h = (xq >> 2) ? (k_ == 0 ? 6 : k_ == 1 ? 5 : k_ == 2 ? 2 : 0) : (k_ == 0 ? 7 : k_ == 1 ? 4 : k_ == 2 ? 3 : 1);
                    att::attn_unit(b, h, qb, QB, KB, VB, OB, KN2, lam, onemli, args.in[11] + l * 128, (char*)lds, wave); }
                    continue; }
            if (PH_EN(13) && !((MK_DUP_KIND == 12 || MK_DUP_KIND >= 14) && rep_ == 1)) { const int uid = xq * 32 + (uq - 128); const int lane = att::lane_id_asm(), tid = wave * 64 + lane;
                const int ch = uid >> 1, gh = uid & 1; const size_t tok0 = (size_t)ch * 128;
                LAS float* st = (LAS float*)(ldsl + LDSCTL_OFF + 2048);
                v4u xa[2][8], xb[2][8];
#pragma unroll
                for (int rb = 0; rb < 2; ++rb)
#pragma unroll
                    for (int rr = 0; rr < 8; ++rr) { const bf16* vp = VGB + (tok0 + wave * 16 + rb * 8 + rr) * 1024 + lane * 8; xa[rb][rr] = *(const v4u*)vp; xb[rb][rr] = *(const v4u*)(vp + 512); }
                __builtin_amdgcn_sched_barrier(0);
#pragma unroll
                for (int rb = 0; rb < 2; ++rb) {
#pragma unroll
                    for (int rr = 0; rr < 8; ++rr) { const v4u a = xa[rb][rr], b2 = xb[rb][rr]; const int row = wave * 16 + rb * 8 + rr;
                        float x[16] = {bflo(a.x), bfhi(a.x), bflo(a.y), bfhi(a.y), bflo(a.z), bfhi(a.z), bflo(a.w), bfhi(a.w), bflo(b2.x), bfhi(b2.x), bflo(b2.y), bfhi(b2.y), bflo(b2.z), bfhi(b2.z), bflo(b2.w), bfhi(b2.w)};
                        float s = 0.f;
#pragma unroll
                        for (int q = 0; q < 16; ++q) s += x[q];
                        const float mean = wave_sum(s) * (1.f / 1024.f); float s2 = 0.f;
#pragma unroll
                        for (int q = 0; q < 16; ++q) { const float d = x[q] - mean; s2 += d * d; }
                        const float rstd = __builtin_amdgcn_rsqf(wave_sum(s2) * (1.f / 1024.f) + NORM_EPS);
                        if (lane == 0) { st[row * 2] = mean; st[row * 2 + 1] = rstd; } } }
                __syncthreads();
#pragma nounroll
                for (int gp = 0; gp < 2; ++gp) {
                    att::bf16x8 pa[8];
                    { const int gs = wave >> 2, tb = wave & 3, g = gh * 4 + gp * 2 + gs, r32 = lane & 31, hi2 = lane >> 5;
                      const bf16* wp = WSPB + (((size_t)l * 8 + g) * 128 + tb * 32 + r32) * 128 + hi2 * 8;
#pragma unroll
                      for (int ks = 0; ks < 8; ++ks) pa[ks] = *(const att::bf16x8*)(wp + ks * 16);
                      __builtin_amdgcn_sched_barrier(0); }
                    { const int sr = tid >> 4, sc = (tid & 15) * 8;
#pragma unroll
                    for (int gs = 0; gs < 2; ++gs) { const int g = gh * 4 + gp * 2 + gs; const int colg = g * 128 + sc;
                        const f32x4g lg0 = *(const f32x4g*)(args.in[12] + l * 1024 + colg), lg1 = *(const f32x4g*)(args.in[12] + l * 1024 + colg + 4);
                        const f32x4g lb0 = *(const f32x4g*)(args.in[13] + l * 1024 + colg), lb1 = *(const f32x4g*)(args.in[13] + l * 1024 + colg + 4);
                        v4u av[4];
#pragma unroll
                        for (int q = 0; q < 4; ++q) av[q] = *(const v4u*)(VGB + (tok0 + sr + 32 * q) * 1024 + colg);
#pragma unroll
                        for (int q = 0; q < 4; ++q) { const int row = sr + 32 * q; const v4u a = av[q];
                            const float mean = st[row * 2], rstd = st[row * 2 + 1];
                            v4u o; o.x = pk2((bflo(a.x) - mean) * rstd * lg0.x + lb0.x, (bfhi(a.x) - mean) * rstd * lg0.y + lb0.y);
                            o.y = pk2((bflo(a.y) - mean) * rstd * lg0.z + lb0.z, (bfhi(a.y) - mean) * rstd * lg0.w + lb0.w);
                            o.z = pk2((bflo(a.z) - mean) * rstd * lg1.x + lb1.x, (bfhi(a.z) - mean) * rstd * lg1.y + lb1.y);
                            o.w = pk2((bflo(a.w) - mean) * rstd * lg1.z + lb1.z, (bfhi(a.w) - mean) * rstd * lg1.w + lb1.w);
                            *(LAS v4u*)(ldsl + gs * 32768 + (row >> 6) * 16384 + att::v_st(row & 63, sc)) = o; } } }
                    __syncthreads();
                    v4u uu8[8]; float bsv8[8];
#pragma unroll
                    for (int i = 0; i < 8; ++i) { const int c = tid + 512 * i, gs = c >> 11, t = (c >> 4) & 127, k0 = (c & 15) * 8, g = gh * 4 + gp * 2 + gs;
                        bsv8[i] = args.in[15][((size_t)l * 8 + g) * 128 + t]; uu8[i] = *(const v4u*)(UB + (tok0 + t) * 1024 + g * 128 + k0); }
                    __builtin_amdgcn_sched_barrier(0);
                    { const int gs = wave >> 2, tb = wave & 3, g = gh * 4 + gp * 2 + gs, r32 = lane & 31, hi2 = lane >> 5;
                      att::f32x16 o[4] = {};
                      const int vb = (int)(uintptr_t)(lds + gs * 32768) + att::v_rd_base(lane);
                      att::pv_d0(o, vb, pa[0], pa[1], pa[2], pa[3]);
                      att::pv_d0(o, vb + 16384, pa[4], pa[5], pa[6], pa[7]);
                      __syncthreads();
                      LAS float* ot = (LAS float*)(ldsl + gs * 65536) + (tb * 32 + 4 * hi2) * 128 + r32;
#pragma unroll
                      for (int r = 0; r < 16; ++r)
#pragma unroll
                          for (int d0 = 0; d0 < 4; ++d0) ot[((r & 3) + 8 * (r >> 2)) * 128 + d0 * 32] = o[d0][r]; }
                    __syncthreads();
#pragma unroll
                    for (int i = 0; i < 8; ++i) { const int c = tid + 512 * i, gs = c >> 11, t = (c >> 4) & 127, k0 = (c & 15) * 8, g = gh * 4 + gp * 2 + gs;
                        const LAS float* op = (const LAS float*)(ldsl + gs * 65536) + t * 128 + k0;
                        const f32x4g m0 = *(const LAS f32x4g*)op, m1 = *(const LAS f32x4g*)(op + 4);
                        const float bsv = bsv8[i];
                        const size_t off = (tok0 + t) * 1024 + g * 128 + k0;
                        const v4u uu = uu8[i];
                        v4u w; w.x = pk2(bflo(uu.x) * (m0.x + bsv), bfhi(uu.x) * (m0.y + bsv)); w.y = pk2(bflo(uu.y) * (m0.z + bsv), bfhi(uu.y) * (m0.w + bsv));
                        w.z = pk2(bflo(uu.z) * (m1.x + bsv), bfhi(uu.z) * (m1.y + bsv)); w.w = pk2(bflo(uu.w) * (m1.z + bsv), bfhi(uu.w) * (m1.w + bsv));
                        *(v4u*)(SGB + off) = w; }
                    __syncthreads();
                }
            } } }
            SEAM(pb + 1);
        }
        if (PH_EN(4) && IN(pb + 2)) for (int rep_ = 0; rep_ < DUPN(4); ++rep_) { PHASE_ENV();
            { pg8::Gemm g{OB, (const bf16*)(GAS bf16*)(wl + W_A), 2 * M, 2 * D, D}; pg8::AbOrder S; S.S.init(M, D, G, bx); pg8::EpiGate2 E{GAB, MRG};
              pg8::gemm_phase<pg8::EpiGate2, pg8::AbOrder, true, true>(ldsl, g, S, E, wave); }
            SEAM(pb + 2);
        }
        if (PH_EN(5) && IN(pb + 3)) for (int rep_ = 0; rep_ < DUPN(5); ++rep_) { PHASE_ENV();
            pg8::Gemm g{MRG, (const bf16*)(GAS bf16*)(wl + W_O), M, D, D}; pg8::StaticOrder S; S.init(M, D, G, bx); pg8::EpiYb E{Y};
            pg8::gemm_phase<pg8::EpiYb, pg8::StaticOrder, true, true>(ldsl, g, S, E, wave);
            SEAM(pb + 3);
        }
        if (PH_EN(6) && IN(pb + 4)) for (int rep_ = 0; rep_ < DUPN(6); ++rep_) { PHASE_ENV(); PHASE_IDS();
            bf16* const xo_ = (DUPN(6) == 2 && rep_ == 0) ? (bf16*)O1S : XR; bf16* const h2o_ = (DUPN(6) == 2 && rep_ == 0) ? (bf16*)O1S + (size_t)M * D : H2;
            LAS float* wr = (LAS float*)ldsl;
            { const float* wrg = args.in[21] + (size_t)l * 1024 * NE;
              for (int i = tid; i < 1024 * NE; i += 512) wr[(i & 15) * 1028 + (i >> 4)] = wrg[i]; }
            __syncthreads();
            const bf16* xin = XR;
            const int e_l = ((lane >> 5) & 1) * 8 + ((lane >> 4) & 1) * 4 + ((lane >> 3) & 1) * 2 + ((lane >> 2) & 1);
            const float br = args.in[22][l * NE + e_l];
            u32x2 ny[4]; u32x2 nx[4];
#pragma unroll
            for (int j = 0; j < 4; ++j) { ny[j] = __builtin_nontemporal_load((const u32x2*)(Y + (size_t)gw * D + 4 * lane + 256 * j)); nx[j] = *(const u32x2*)(xin + (size_t)gw * D + 4 * lane + 256 * j); }
#pragma nounroll
            for (int bb = 0; bb < BATCH; ++bb) { const float* md = md0 + (size_t)bb * 6144;
              f32x4g PA[4], PB[4], PS[4];
              { const float* gpo = args.in[5] + l * 1024; const float* gpr = args.in[19] + l * 1024;
#pragma unroll
                for (int j = 0; j < 4; ++j) { const int col = 4 * lane + 256 * j;
                    const f32x4g gp = *(const GAS f32x4g*)(gpo + col), gt = *(const GAS f32x4g*)(md + 2048 + col);
                    const f32x4g gv = *(const GAS f32x4g*)(gpr + col), sv = *(const GAS f32x4g*)(md + 3072 + col), cv = *(const GAS f32x4g*)(md + 4096 + col);
                    PA[j] = gt * gp; PB[j] = gv * (cv + 1.0f); PS[j] = sv; } }
#pragma nounroll
              for (int k4 = 0; k4 < 4; ++k4) { const int m = gw + (bb * 4 + k4) * NGW;
                f32x4g v[4], xv[4]; float s = 0.f;
#pragma unroll
                for (int j = 0; j < 4; ++j) { const u32x2 yb_ = ny[j]; v[j] = (f32x4g){bflo(yb_.x), bfhi(yb_.x), bflo(yb_.y), bfhi(yb_.y)}; xv[j] = (f32x4g){bflo(nx[j].x), bfhi(nx[j].x), bflo(nx[j].y), bfhi(nx[j].y)}; }
                { const int mn = (m + NGW < M) ? m + NGW : m;
#pragma unroll
                  for (int j = 0; j < 4; ++j) { ny[j] = __builtin_nontemporal_load((const u32x2*)(Y + (size_t)mn * D + 4 * lane + 256 * j)); nx[j] = *(const u32x2*)(xin + (size_t)mn * D + 4 * lane + 256 * j); }
                  __builtin_amdgcn_sched_barrier(0); }
#pragma unroll
                for (int j = 0; j < 4; ++j) s += (v[j].x * v[j].x + v[j].y * v[j].y) + (v[j].z * v[j].z + v[j].w * v[j].w);
                const float rstd = __builtin_amdgcn_rsqf(wave_sum(s) * (1.f / D) + NORM_EPS); float s2 = 0.f;
#pragma unroll
                for (int j = 0; j < 4; ++j) { const int col = 4 * lane + 256 * j;
                    v[j] = xv[j] + (v[j] * rstd) * PA[j];
                    { u32x2 w_; w_.x = pk2(v[j].x, v[j].y); w_.y = pk2(v[j].z, v[j].w); *(u32x2*)(xo_ + (size_t)m * D + col) = w_; }
                    s2 += (v[j].x * v[j].x + v[j].y * v[j].y) + (v[j].z * v[j].z + v[j].w * v[j].w); }
                const float rstd2 = __builtin_amdgcn_rsqf(wave_sum(s2) * (1.f / D) + NORM_EPS);
                float acc[16];
#pragma unroll
                for (int e = 0; e < 16; ++e) acc[e] = 0.f;
                f32x4g hq[4];
#pragma unroll
                for (int j = 0; j < 4; ++j) { const int col = 4 * lane + 256 * j;
                    hq[j] = (v[j] * rstd2) * PB[j] + PS[j];
                    *(unsigned*)((unsigned char*)h2o_ + (size_t)m * D + col) = pg8::pk4_fp8(hq[j].x, hq[j].y, hq[j].z, hq[j].w); }
                f32x4g wq[2][4];
#define ROW1_LDG(buf_, g_) do { _Pragma("unroll") for (int q = 0; q < 4; ++q) wq[buf_][q] = *(const LAS f32x4g*)(wr + (4 * ((g_) & 3) + q) * 1028 + 4 * lane + 256 * ((g_) >> 2)); } while (0)
                ROW1_LDG(0, 0);
#pragma unroll
                for (int g = 0; g < 16; ++g) {
                    if (g + 1 < 16) ROW1_LDG((g + 1) & 1, g + 1);
                    asm volatile("" ::: "memory");
                    const f32x4g h = hq[g >> 2];
#pragma unroll
                    for (int q = 0; q < 4; ++q) { const f32x4g wv = wq[g & 1][q]; acc[4 * (g & 3) + q] += (h.x * wv.x + h.y * wv.y) + (h.z * wv.z + h.w * wv.w); }
                    asm volatile("" ::: "memory"); }
#undef ROW1_LDG
                { const bool up = (lane & 32) != 0;
#pragma unroll
                  for (int i = 0; i < 8; ++i) { const float keep = up ? acc[i + 8] : acc[i], send = up ? acc[i] : acc[i + 8];
                      auto rr = __builtin_amdgcn_permlane32_swap(__float_as_uint(send), __float_as_uint(send), false, false); acc[i] = keep + __uint_as_float(up ? rr[0] : rr[1]); } }
                { const bool up = (lane & 16) != 0;
#pragma unroll
                  for (int i = 0; i < 4; ++i) { const float keep = up ? acc[i + 4] : acc[i], send = up ? acc[i] : acc[i + 4]; acc[i] = keep + xl_xor<16>(send); } }
                { const bool up = (lane & 8) != 0;
#pragma unroll
                  for (int i = 0; i < 2; ++i) { const float keep = up ? acc[i + 2] : acc[i], send = up ? acc[i] : acc[i + 2]; acc[i] = keep + att::dpp_mov<0x128>(send); } }
                { const bool up = (lane & 4) != 0; const float keep = up ? acc[1] : acc[0], send = up ? acc[0] : acc[1]; acc[0] = keep + att::dpp_mov<0x141>(send); }
                float lg = acc[0]; lg += att::dpp_mov<0x4E>(lg); lg += att::dpp_mov<0xB1>(lg); lg += br;
                float mx = xl_max32(lg); mx = fmaxf(mx, xl_xor<16>(mx)); mx = fmaxf(mx, att::dpp_mov<0x128>(mx)); mx = fmaxf(mx, att::dpp_mov<0x141>(mx));
                const float ex = __expf(lg - mx); float sm = xl_add32(ex); sm += xl_xor<16>(sm); sm += att::dpp_mov<0x128>(sm); sm += att::dpp_mov<0x141>(sm);
                if ((lane & 3) == 0) AFF[(size_t)m * NE + e_l] = ex / sm;
                if (lane < 16) SLOTMAP[(size_t)m * NE + lane] = 0;
              } }
            SEAM(pb + 4);
        }
        if (PH_EN(7) && IN(pb + 5)) for (int rep_ = 0; rep_ < DUPN(7); ++rep_) { PHASE_ENV(); PHASE_IDS();
            for (int uid = vcu; uid < BATCH * NE; uid += G) { const int b = uid / NE, e = uid % NE;
                LAS unsigned* hist = (LAS unsigned*)ldsl; LAS unsigned* sh = hist + 256;
                float v[16]; unsigned bits[16]; const int t0 = tid * 16;
#pragma unroll
                for (int i = 0; i < 16; ++i) { v[i] = AFF[((size_t)b * SEQ + t0 + i) * NE + e]; bits[i] = __float_as_uint(v[i]); }
                unsigned pref = 0, need = CAP;
#pragma nounroll
                for (int pass = 0; pass < 4; ++pass) { const int shift = 24 - 8 * pass;
                    if (tid < 256) hist[tid] = 0u; __syncthreads();
#pragma unroll
                    for (int i = 0; i < 16; ++i) { const bool in = (unsigned)((unsigned long long)bits[i] >> (shift + 8)) == pref; if (in) atomicAdd((unsigned*)&hist[(bits[i] >> shift) & 255u], 1u); }
                    __syncthreads();
                    if (wave == 0) { const unsigned h0 = hist[4 * lane], h1 = hist[4 * lane + 1], h2 = hist[4 * lane + 2], h3 = hist[4 * lane + 3]; const unsigned c = h0 + h1 + h2 + h3;
                        unsigned s = c;
#pragma unroll
                        for (int o = 1; o < 64; o <<= 1) { const unsigned t = xl_idx(s, (lane + o) & 63); if (lane + o < 64) s += t; }
                        const unsigned above = s - c;
                        if (above < need && need <= s) { unsigned a = above; unsigned dsel, nn;
                            if (a + h3 >= need) { dsel = 3; nn = need - a; } else { a += h3;
                            if (a + h2 >= need) { dsel = 2; nn = need - a; } else { a += h2;
                            if (a + h1 >= need) { dsel = 1; nn = need - a; } else { a += h1; dsel = 0; nn = need - a; } } }
                            sh[0] = 4 * lane + dsel; sh[1] = nn; } }
                    __syncthreads();
                    pref = (pref << 8) | sh[0]; need = sh[1];
                    __syncthreads();
                }
                const unsigned thr = pref; unsigned ngt = 0, neq = 0;
#pragma unroll
                for (int i = 0; i < 16; ++i) { ngt += bits[i] > thr ? 1u : 0u; neq += bits[i] == thr ? 1u : 0u; }
                const unsigned packed = ngt | (neq << 16); unsigned inc = packed;
#pragma unroll
                for (int o = 1; o < 64; o <<= 1) { const unsigned t = xl_idx(inc, (lane - o) & 63); if (lane >= o) inc += t; }
                if (lane == 63) sh[8 + wave] = inc; __syncthreads();
                unsigned wbase = 0;
                for (int w = 0; w < wave; ++w) wbase += sh[8 + w];
                const unsigned exc = wbase + inc - packed; unsigned gtb = exc & 0xffffu, eqb = exc >> 16;
#pragma unroll
                for (int i = 0; i < 16; ++i) { const bool gt = bits[i] > thr, eq = bits[i] == thr;
                    if (gt || (eq && eqb < need)) { const unsigned slot = gtb + (eqb < need ? eqb : need); const int row = e * 2048 + b * 1024 + (int)slot; const int tok = b * SEQ + t0 + i;
                        IDX[row] = tok; GATEV[row] = v[i]; SLOTMAP[(size_t)tok * NE + e] = row + 1; }
                    gtb += gt ? 1u : 0u; eqb += eq ? 1u : 0u; }
                __syncthreads();
            }
            SEAM(pb + 5);
        }
        if (PH_EN(9) && IN(pb + 7)) for (int rep_ = 0; rep_ < DUPN(9); ++rep_) { PHASE_ENV(); PHASE_IDS();
            pg8::MoeOrder1 S{vcu, G};
            LAS int* tokl = (LAS int*)(ldsl + LDSCTL_OFF + 4096);
            for (int q = tid; q < 8 * 256; q += 512) { pg8::Unit u; if (S.next(q >> 8, u)) tokl[q] = IDX[u.pm * 256 + (q & 255)]; }
            __syncthreads();
            pg8::Gemm g{H2, (const bf16*)(GAS bf16*)(wl + W_GU), NSEL, NE * 4096, D / 2}; pg8::EpiMoe1 E{(unsigned char*)HID, 1.0f / W8_SCALE};
            pg8::gemm_phase<pg8::EpiMoe1, pg8::MoeOrder1, true, true, true, 0, W8_E8M0>(ldsl, g, S, E, wave, tokl);
            SEAM(pb + 7);
        }
        if (PH_EN(10) && IN(pb + 8)) for (int rep_ = 0; rep_ < DUPN(10); ++rep_) { PHASE_ENV();
            pg8::Gemm g{HID, (const bf16*)(GAS bf16*)(wl + W_D), NSEL, NE * 1024, FF / 2}; pg8::MoeOrder2 S{vcu, G}; pg8::EpiMoe2 E{YC, GATEV, 1.0f / W8_SCALE};
            pg8::gemm_phase<pg8::EpiMoe2, pg8::MoeOrder2, true, true, false, 0, W8_E8M0>(ldsl, g, S, E, wave);
            SEAM(pb + 8);
        }
        if (PH_EN(11) && IN(pb + 9)) for (int rep_ = 0; rep_ < DUPN(11); ++rep_) { PHASE_ENV(); PHASE_IDS();
            bf16* const xo_ = (DUPN(11) == 2 && rep_ == 0) ? (bf16*)O1S : XR; bf16* const xno_ = (DUPN(11) == 2 && rep_ == 0) ? (bf16*)O1S + (size_t)M * D : XN;
            int smn = 0;
            if (gw < M) smn = SLOTMAP[(size_t)gw * NE + (lane & 15)];
            u32x2 nxr[4];
#pragma unroll
            for (int j = 0; j < 4; ++j) nxr[j] = *(const u32x2*)(XR + (size_t)gw * D + 4 * lane + 256 * j);
#pragma nounroll
            for (int bb = 0; bb < BATCH; ++bb) { const float* md = md0 + (size_t)bb * 6144;
              f32x4g RPA[4], RPB[4], RPS[4];
#pragma unroll
              for (int j = 0; j < 4; ++j) { const int col = 4 * lane + 256 * j;
                  RPA[j] = *(const f32x4g*)(args.in[20] + l * 1024 + col) * *(const f32x4g*)(md + 5120 + col);
                  if (l + 1 < DEPTH) { const float* mdn = md + (size_t)BATCH * 6144;
                      RPB[j] = *(const f32x4g*)(args.in[4] + (l + 1) * 1024 + col) * (*(const f32x4g*)(mdn + 1024 + col) + 1.0f); RPS[j] = *(const f32x4g*)(mdn + col); }
                  else { RPB[j] = (f32x4g){0.f, 0.f, 0.f, 0.f}; RPS[j] = RPB[j]; } }
#pragma nounroll
              for (int k4 = 0; k4 < 4; ++k4) { const int m = gw + (bb * 4 + k4) * NGW;
                const int sm = smn; f32x4g xv[4];
#pragma unroll
                for (int j = 0; j < 4; ++j) xv[j] = (f32x4g){bflo(nxr[j].x), bfhi(nxr[j].x), bflo(nxr[j].y), bfhi(nxr[j].y)};
                { const int mn = (m + NGW < M) ? m + NGW : m;
                  if (m + NGW < M) smn = SLOTMAP[(size_t)mn * NE + (lane & 15)];
#pragma unroll
                  for (int j = 0; j < 4; ++j) nxr[j] = *(const u32x2*)(XR + (size_t)mn * D + 4 * lane + 256 * j);
                  __builtin_amdgcn_sched_barrier(0); }
                f32x4g y[4];
#pragma unroll
                for (int j = 0; j < 4; ++j) y[j] = (f32x4g){0.f, 0.f, 0.f, 0.f};
                unsigned mk = (unsigned)__ballot(sm != 0) & 0xffffu;
                while (mk != 0u) {
                    const int e0 = __builtin_ctz(mk); mk &= mk - 1u;
                    const int e1 = mk ? __builtin_ctz(mk) : -1; if (e1 >= 0) mk &= mk - 1u;
                    const int e2 = (e1 >= 0 && mk) ? __builtin_ctz(mk) : -1; if (e2 >= 0) mk &= mk - 1u;
                    const int e3 = (e2 >= 0 && mk) ? __builtin_ctz(mk) : -1; if (e3 >= 0) mk &= mk - 1u;
                    u32x2 w0[4], w1[4], w2[4], w3[4];
#pragma unroll
                    for (int j = 0; j < 4; ++j) { w1[j] = (u32x2){0u, 0u}; w2[j] = (u32x2){0u, 0u}; w3[j] = (u32x2){0u, 0u}; }
#define ROW2_LD(w_, e_) do { const u32x2* yp_ = (const u32x2*)(YC + (size_t)(__builtin_amdgcn_readlane(sm, e_) - 1) * D) + lane; _Pragma("unroll") for (int j = 0; j < 4; ++j) w_[j] = __builtin_nontemporal_load(yp_ + 64 * j); } while (0)
#define ROW2_AC(w_) do { _Pragma("unroll") for (int j = 0; j < 4; ++j) y[j] += (f32x4g){bflo(w_[j].x), bfhi(w_[j].x), bflo(w_[j].y), bfhi(w_[j].y)}; } while (0)
                    ROW2_LD(w0, e0); if (e1 >= 0) ROW2_LD(w1, e1); if (e2 >= 0) ROW2_LD(w2, e2); if (e3 >= 0) ROW2_LD(w3, e3);
                    ROW2_AC(w0); ROW2_AC(w1); ROW2_AC(w2); ROW2_AC(w3);
#undef ROW2_LD
#undef ROW2_AC
                }
                float s = 0.f;
#pragma unroll
                for (int j = 0; j < 4; ++j) s += (y[j].x * y[j].x + y[j].y * y[j].y) + (y[j].z * y[j].z + y[j].w * y[j].w);
                const float rstd = __builtin_amdgcn_rsqf(wave_sum(s) * (1.f / D) + NORM_EPS); float s2 = 0.f;
                f32x4g* xw = (f32x4g*)(XOUT + (size_t)m * D) + lane; f32x4g v[4];
#pragma unroll
                for (int j = 0; j < 4; ++j) { const int col = 4 * lane + 256 * j;
                    v[j] = xv[j] + (y[j] * rstd) * RPA[j];
                    if (l + 1 < DEPTH) { u32x2 w_; w_.x = pk2(v[j].x, v[j].y); w_.y = pk2(v[j].z, v[j].w); *(u32x2*)(xo_ + (size_t)m * D + col) = w_; } else xw[64 * j] = v[j];
                    s2 += (v[j].x * v[j].x + v[j].y * v[j].y) + (v[j].z * v[j].z + v[j].w * v[j].w); }
                if (l + 1 < DEPTH) { const float rstd2 = __builtin_amdgcn_rsqf(wave_sum(s2) * (1.f / D) + NORM_EPS);
#pragma unroll
                    for (int j = 0; j < 4; ++j) { const int col = 4 * lane + 256 * j; const f32x4g h = (v[j] * rstd2) * RPB[j] + RPS[j];
                        u32x2 w; w.x = pk2(h.x, h.y); w.y = pk2(h.z, h.w); *(u32x2*)(xno_ + (size_t)m * D + col) = w;
                        *(unsigned*)(XN8 + (size_t)m * D + col) = pg8::pk4_fp8(h.x, h.y, h.z, h.w); } }
              } }
            if (l + 1 < DEPTH && gw * 128 < M * 16) { unsigned z_ = 0u; asm volatile("" : "+v"(z_)); *(u32x2*)(KN2 + gw * 128 + 2 * lane) = (u32x2){z_, z_}; }
            SEAM(pb + 9);
        }
    }
#undef IN
#undef SEAM
}

extern "C" void kernel_launch(void* const* d_in, const int* in_sizes, int n_in, void* d_out, int out_size, void* d_ws, size_t ws_size, hipStream_t stream) {
    static int grid = 0;
    if (grid == 0) {
        if (n_in != 26 || in_sizes[0] != M * D || out_size != M * D || ws_size < WS_END) { fprintf(stderr, "kernel_launch: unexpected shapes (n_in %d, in0 %d, out %d, ws %zu < %zu); nothing launched\n", n_in, n_in > 0 ? in_sizes[0] : -1, out_size, ws_size, (size_t)WS_END); grid = -1; return; }
        int dev = 0, cus = 0, per_cu = 0;
        if (hipGetDevice(&dev) != hipSuccess || hipDeviceGetAttribute(&cus, hipDeviceAttributeMultiprocessorCount, dev) != hipSuccess) { grid = -1; return; }
        if (hipFuncSetAttribute((const void*)mk_fwd, hipFuncAttributeMaxDynamicSharedMemorySize, LDS_BYTES) != hipSuccess) { fprintf(stderr, "kernel_launch: hipFuncSetAttribute failed\n"); grid = -1; return; }
        if (hipOccupancyMaxActiveBlocksPerMultiprocessor(&per_cu, (const void*)mk_fwd, NWAVES * 64, LDS_BYTES) != hipSuccess || per_cu < 1) { fprintf(stderr, "kernel_launch: occupancy query says %d\n", per_cu); }
        (void)hipGetLastError();
        grid = 256;
        if (cus < 256) { fprintf(stderr, "kernel_launch: built for a 256-CU device (per-workgroup token lists hold 8 expert-GEMM units); %d CUs: nothing launched\n", cus); grid = -1; return; }
    }
    if (grid < 0) return;
    (void)hipMemsetAsync((char*)d_ws + WS_CTL, 0, CTL_ZERO_BYTES, stream);
    Args a{};
    for (int i = 0; i < 26; ++i) a.in[i] = (const float*)d_in[i];
    a.out = (float*)d_out; a.ws = (unsigned char*)d_ws; a.pad = 0;
#if MK_SINGLE
    a.ph_lo = 0; a.ph_hi = NPHASE; a.single = 1;
    hipLaunchKernelGGL(mk_fwd, dim3(grid), dim3(NWAVES * 64), LDS_BYTES, stream, a);
#else
    a.single = 0;
#ifndef MK_PROBE_STOP
#define MK_PROBE_STOP NPHASE
#endif
    for (int p = 0; p < MK_PROBE_STOP; ++p) { a.ph_lo = p; a.ph_hi = p + 1; hipLaunchKernelGGL(mk_fwd, dim3(grid), dim3(NWAVES * 64), LDS_BYTES, stream, a); }
#ifdef MK_PROBE_COPY_OFF
    (void)hipMemcpyAsync(d_out, (char*)d_ws + (MK_PROBE_COPY_OFF), (size_t)M * D * 4, hipMemcpyDeviceToDevice, stream);
#endif
#endif
}
```

```cpp
#include <hip/hip_runtime.h>
#include <hip/hip_bf16.h>
#include <cstdio>
#include <cstdint>
namespace pg8 {
#define PG8_LAS __attribute__((address_space(3)))
typedef unsigned short bf16_t;
typedef short bf16x8 __attribute__((ext_vector_type(8)));
typedef float f32x4 __attribute__((ext_vector_type(4)));
typedef unsigned u32x4 __attribute__((ext_vector_type(4)));
constexpr int BM = 256, BK = 64, HALF = 128, HTB = HALF * BK * 2  , STAGE_BYTES = 8 * HTB, NXCD = 8, WGM = 8;

__host__ __device__ __forceinline__ int lds_byte(int r, int c) { const int st = (r >> 4) * 2 + (c >> 5), rr = r & 15, cc = c & 31, ob = rr * 64 + cc * 2; return st * 1024 + (ob ^ (((ob >> 9) & 1) << 5)); }
__host__ __device__ __forceinline__ void stage_rc(int b, int& R, int& C) { const int st = b / 1024, sb = b % 1024, swz = sb ^ (((sb >> 9) & 1) << 5); R = (st >> 1) * 16 + swz / 64; C = (st & 1) * 32 + (swz % 64) / 2; }
__host__ __device__ __forceinline__ int perm32(int rho) { const int n = rho >> 4, i = rho & 15; return 8 * (i >> 2) + 4 * n + (i & 3); }

struct Unit { int pm, pn; };
struct Gemm { const bf16_t* A; const bf16_t* Bt; int M, N, K; };

struct StaticOrder {
    int nM, nN, nwg, G, c;
    __host__ __device__ void init(int M, int N, int G_, int c_) { nM = M / BM; nN = N / BM; nwg = nM * nN; G = G_; c = c_; }
    __host__ __device__ bool next(int i, Unit& u) const {
        const long L = (long)i * G + c; if (L >= nwg) return false;
        int wgid = (int)L; { const int q = nwg / NXCD, r = nwg % NXCD, xcd = wgid % NXCD, off = wgid / NXCD; wgid = (xcd < r ? xcd * (q + 1) : r * (q + 1) + (xcd - r) * q) + off; }
        const int nig = WGM * nN, gid = wgid / nig, fm = gid * WGM, gsz = (nM - fm) < WGM ? (nM - fm) : WGM;
        u.pm = fm + ((wgid % nig) % gsz); u.pn = (wgid % nig) / gsz; return true;
    }
    __device__ __forceinline__ void a_ready(const Unit&) const {}
    __device__ __forceinline__ void done(const Unit&) const {}
};

typedef float f32x2c_t __attribute__((ext_vector_type(2))); typedef __bf16 bf16x2c_t __attribute__((ext_vector_type(2)));
__device__ __forceinline__ unsigned cvt_pk_bf16(float lo, float hi) { f32x2c_t v = {lo, hi}; bf16x2c_t b = __builtin_convertvector(v, bf16x2c_t); return __builtin_bit_cast(unsigned, b); }
typedef float f32x2 __attribute__((ext_vector_type(2)));
__device__ __forceinline__ f32x2 gelu_pk(f32x2 v) {
    const f32x2 av = __builtin_elementwise_abs(v), d = av * 0.2316418882f + 1.0f;
    f32x2 t; t.x = __builtin_amdgcn_rcpf(d.x); t.y = __builtin_amdgcn_rcpf(d.y);
    f32x2 q = t * 0.5307027145f + (-0.7265760135f); q = q * t + 0.7107068705f; q = q * t + (-0.142248368f); q = q * t + 0.127414796f; q = q * t;
    const f32x2 s = (v * v) * (-0.72134752044f);
    f32x2 e; e.x = __builtin_amdgcn_exp2f(s.x); e.y = __builtin_amdgcn_exp2f(s.y);
    const f32x2 m = v * (q * e), r = v - m;
    f32x2 o; o.x = v.x < 0.f ? m.x : r.x; o.y = v.y < 0.f ? m.y : r.y; return o;
}

template <class Epi, class Sched, bool ALIGN_EPI = false, bool SP2 = false, bool GATHER = false, int BAUX = 0  ,
          int F8 = 0  >
__device__ __forceinline__ void gemm_phase(PG8_LAS unsigned char* lds, const Gemm g, const Sched& S, const Epi& E, const int wid_in  , const PG8_LAS int* tokl = nullptr) {
    int lane_; asm volatile("v_mbcnt_lo_u32_b32 %0, -1, 0\n\tv_mbcnt_hi_u32_b32 %0, -1, %0" : "=v"(lane_));
    const int wid = wid_in, lane = lane_, tid = wid * 64 + lane, wr = wid >> 2, wc = wid & 3, fr = lane & 15, fq = lane >> 4;
    const int K = g.K, nt = K / BK;
    unsigned voffA[2], voffB[2];
    int RA[2], CA[2];
#pragma unroll
    for (int i = 0; i < 2; ++i) { int R, C; stage_rc(tid * 16 + i * 8192, R, C); const int Rb = Epi::PERM ? ((R & ~31) + perm32(R & 31)) : R; RA[i] = R; CA[i] = C;
        voffA[i] = (unsigned)(R * K + C) * 2u; voffB[i] = (unsigned)(Rb * K + C) * 2u; }
    unsigned gA0[2] = {0u, 0u}, gA1[2] = {0u, 0u}, gN0[2] = {0u, 0u}, gN1[2] = {0u, 0u};
#define PG8_GLOAD(d0_, d1_, ui_) do { _Pragma("unroll") for (int i_ = 0; i_ < 2; ++i_) { d0_[i_] = (unsigned)tokl[(ui_) * 256 + RA[i_]] * (unsigned)(K * 2) + (unsigned)(CA[i_] * 2); \
        d1_[i_] = (unsigned)tokl[(ui_) * 256 + 128 + RA[i_]] * (unsigned)(K * 2) + (unsigned)(CA[i_] * 2); } } while (0)
    const size_t kstep = (size_t)(BK * 2);
    const size_t hstep = (size_t)HALF * K * 2;
    const size_t hstepA = GATHER ? (size_t)0 : hstep;
    const size_t tstep = 2 * hstep;
    const unsigned ldsw = (unsigned)wid * 1024u;
    const int aoff = lds_byte(wr * 64 + fr, F8 == 2 ? fq * 16 : fq * 8), boff = lds_byte(wc * 32 + fr, F8 == 2 ? fq * 16 : fq * 8);
    constexpr int kfr = F8 == 2 ? 16 : 1024;
    int sc1_ = 127; asm volatile("" : "+v"(sc1_));
#define PG8_SA(b, h) (((b) * 2 + (h)) * HTB)
#define PG8_SB(b, h) ((4 + (b) * 2 + (h)) * HTB)
    const size_t rstep = (size_t)64 * K * 2;
#define PG8_STAGE(bufoff, gbase, voff) do { _Pragma("unroll") for (int _i = 0; _i < 2; ++_i) \
        __builtin_amdgcn_global_load_lds((const unsigned*)((const char*)(gbase) + (GATHER ? (size_t)0 : (size_t)_i * rstep) + (voff)[GATHER ? _i : 0]), (PG8_LAS unsigned*)(lds + (bufoff) + ldsw + _i * 8192), 16, 0, 0); } while (0)
#define PG8_STAGEB(bufoff, gbase, voff) do { _Pragma("unroll") for (int _i = 0; _i < 2; ++_i) \
        __builtin_amdgcn_global_load_lds((const unsigned*)((const char*)(gbase) + (size_t)_i * rstep + (voff)[0]), (PG8_LAS unsigned*)(lds + (bufoff) + ldsw + _i * 8192), 16, 0, BAUX); } while (0)
#define PG8_LDA(dst, b, h) do { _Pragma("unroll") for (int m = 0; m < 4; ++m) _Pragma("unroll") for (int k = 0; k < 2; ++k) dst[m][k] = *(const PG8_LAS bf16x8*)(lds + PG8_SA(b, h) + aoff + m * 2048 + k * kfr); } while (0)
#define PG8_LDB(dst, b, h) do { _Pragma("unroll") for (int n = 0; n < 2; ++n) _Pragma("unroll") for (int k = 0; k < 2; ++k) dst[n][k] = *(const PG8_LAS bf16x8*)(lds + PG8_SB(b, h) + boff + n * 2048 + k * kfr); } while (0)
typedef long pg8_i64x2 __attribute__((ext_vector_type(2)));
typedef int pg8_i32x4 __attribute__((ext_vector_type(4))); typedef int pg8_i32x8 __attribute__((ext_vector_type(8)));
#define PG8_CAT8(lo_, hi_) __builtin_shufflevector(__builtin_bit_cast(pg8_i32x4, lo_), __builtin_bit_cast(pg8_i32x4, hi_), 0, 1, 2, 3, 4, 5, 6, 7)
#define PG8_MMA(ai, bj, At, Bt) do { __builtin_amdgcn_s_setprio(1); if constexpr (F8 == 2) { _Pragma("unroll") for (int m = 0; m < 4; ++m) _Pragma("unroll") for (int n = 0; n < 2; ++n) { \
        const pg8_i32x8 w_ = PG8_CAT8(Bt[n][0], Bt[n][1]), x_ = PG8_CAT8(At[m][0], At[m][1]); \
        asm volatile("v_mfma_scale_f32_16x16x128_f8f6f4 %0, %1, %2, %0, %3, %3 op_sel_hi:[0,0,0]" : "+v"(acc[ai][bj][m][n]) : "v"(w_), "v"(x_), "v"(sc1_)); } } else if constexpr (F8 != 0) { _Pragma("unroll") for (int m = 0; m < 4; ++m) _Pragma("unroll") for (int n = 0; n < 2; ++n) _Pragma("unroll") for (int k = 0; k < 2; ++k) { \
        const pg8_i64x2 w_ = __builtin_bit_cast(pg8_i64x2, Bt[n][k]), x_ = __builtin_bit_cast(pg8_i64x2, At[m][k]); \
        acc[ai][bj][m][n] = __builtin_amdgcn_mfma_f32_16x16x32_fp8_fp8(w_[0], x_[0], acc[ai][bj][m][n], 0, 0, 0); acc[ai][bj][m][n] = __builtin_amdgcn_mfma_f32_16x16x32_fp8_fp8(w_[1], x_[1], acc[ai][bj][m][n], 0, 0, 0); } } else { \
        _Pragma("unroll") for (int m = 0; m < 4; ++m) _Pragma("unroll") for (int n = 0; n < 2; ++n) _Pragma("unroll") for (int k = 0; k < 2; ++k) \
        acc[ai][bj][m][n] = __builtin_amdgcn_mfma_f32_16x16x32_bf16(Bt[n][k], At[m][k], acc[ai][bj][m][n], 0, 0, 0); } __builtin_amdgcn_s_setprio(0); } while (0)
#define PG8_WAIT_V(n) asm volatile("s_waitcnt vmcnt(" #n ")" ::: "memory")
#define PG8_WAIT_L(n) asm volatile("s_waitcnt lgkmcnt(" #n ")" ::: "memory")
#define PG8_BAR __builtin_amdgcn_s_barrier()
#define PG8_SCHED __builtin_amdgcn_sched_barrier(0)
    Unit cur, nxt; int ui = 0;
    if (!S.next(0, cur)) return;
    f32x4 acc[2][2][4][2];
#pragma unroll
    for (int a = 0; a < 2; ++a)
#pragma unroll
        for (int b = 0; b < 2; ++b)
#pragma unroll
            for (int m = 0; m < 4; ++m)
#pragma unroll
                for (int n = 0; n < 2; ++n) acc[a][b][m][n] = (f32x4){0.f, 0.f, 0.f, 0.f};
    bf16x8 At[4][2], B0[2][2], B1[2][2];
    const char* cA = GATHER ? (const char*)g.A : (const char*)g.A + (size_t)cur.pm * tstep; const char* cB = (const char*)g.Bt + (size_t)cur.pn * tstep;
    if constexpr (GATHER) PG8_GLOAD(gA0, gA1, 0);
#define PG8_VA0 (GATHER ? gA0 : voffA)
#define PG8_VA1 (GATHER ? gA1 : voffA)
    S.a_ready(cur);
    if constexpr (SP2) {
        PG8_STAGEB(PG8_SB(0, 0), cB, voffB); PG8_STAGEB(PG8_SB(0, 1), cB + hstep, voffB); PG8_STAGE(PG8_SA(0, 0), cA, PG8_VA0); PG8_STAGE(PG8_SA(0, 1), cA + hstepA, PG8_VA1);
        if (wr == 1) PG8_BAR;
        PG8_WAIT_V(2); PG8_BAR;
        PG8_STAGEB(PG8_SB(1, 0), cB + kstep, voffB); PG8_STAGE(PG8_SA(1, 0), cA + kstep, PG8_VA0); PG8_STAGEB(PG8_SB(1, 1), cB + hstep + kstep, voffB);
        PG8_WAIT_V(6); PG8_BAR;
    } else {
        PG8_STAGEB(PG8_SB(0, 0), cB, voffB); PG8_STAGE(PG8_SA(0, 0), cA, PG8_VA0); PG8_STAGEB(PG8_SB(0, 1), cB + hstep, voffB); PG8_STAGE(PG8_SA(0, 1), cA + hstepA, PG8_VA1);
        if (wr == 1) PG8_BAR;
        PG8_WAIT_V(4); PG8_BAR;
        PG8_STAGEB(PG8_SB(1, 0), cB + kstep, voffB); PG8_STAGE(PG8_SA(1, 0), cA + kstep, PG8_VA0); PG8_STAGEB(PG8_SB(1, 1), cB + hstep + kstep, voffB);
        PG8_WAIT_V(6); PG8_BAR;
    }
    for (;;) {
        const bool has_next = S.next(ui + 1, nxt);
        const char* nA = has_next ? (GATHER ? (const char*)g.A : (const char*)g.A + (size_t)nxt.pm * tstep) : cA; const char* nB = has_next ? (const char*)g.Bt + (size_t)nxt.pn * tstep : cB;
        if constexpr (GATHER) { if (has_next) PG8_GLOAD(gN0, gN1, ui + 1); else { gN0[0] = gA0[0]; gN0[1] = gA0[1]; gN1[0] = gA1[0]; gN1[1] = gA1[1]; } }
#define PG8_TRIP(t, PG8_WAIT_VR, PG8_ST11, PG8_WAIT_V3) do { \
            const bool last = (t == nt - 2); \
            const char* a1 = cA + (size_t)(t + 1) * kstep;                                             \
            const char* a2 = last ? nA : cA + (size_t)(t + 2) * kstep; const char* b2 = last ? nB : cB + (size_t)(t + 2) * kstep;     \
            const char* a3 = a2 + kstep; const char* b3 = b2 + kstep;                                \
            unsigned s0[2], s1[2];                                                                 \
            if constexpr (GATHER) { s0[0] = last ? gN0[0] : gA0[0]; s0[1] = last ? gN0[1] : gA0[1]; s1[0] = last ? gN1[0] : gA1[0]; s1[1] = last ? gN1[1] : gA1[1]; } else { s0[0] = s1[0] = voffA[0]; s0[1] = s1[1] = voffA[1]; } \
            if (last && has_next) S.a_ready(nxt); \
            if constexpr (SP2) { \
              \
              \
            PG8_LDB(B0, 0, 0); PG8_LDB(B1, 0, 1); PG8_SCHED; PG8_LDA(At, 0, 0); PG8_ST11(a1); \
            PG8_WAIT_VR(); PG8_WAIT_L(0); PG8_BAR; PG8_MMA(0, 0, At, B0); PG8_MMA(0, 1, At, B1); PG8_BAR; PG8_SCHED; \
              \
            PG8_LDA(At, 0, 1); PG8_STAGEB(PG8_SB(0, 0), b2, voffB); PG8_STAGEB(PG8_SB(0, 1), b2 + hstep, voffB); PG8_STAGE(PG8_SA(0, 0), a2, s0); \
            PG8_WAIT_VR(); PG8_WAIT_L(0); PG8_BAR; PG8_MMA(1, 0, At, B0); PG8_MMA(1, 1, At, B1); PG8_BAR; PG8_SCHED; \
              \
            PG8_LDB(B0, 1, 0); PG8_LDB(B1, 1, 1); PG8_SCHED; PG8_LDA(At, 1, 0); PG8_STAGE(PG8_SA(0, 1), a2 + hstepA, s1); \
            PG8_WAIT_V3(); PG8_WAIT_L(0); PG8_BAR; PG8_MMA(0, 0, At, B0); PG8_MMA(0, 1, At, B1); PG8_BAR; PG8_SCHED; \
              \
            PG8_LDA(At, 1, 1); PG8_STAGEB(PG8_SB(1, 0), b3, voffB); PG8_STAGEB(PG8_SB(1, 1), b3 + hstep, voffB); PG8_STAGE(PG8_SA(1, 0), a3, s0); \
            PG8_WAIT_V(8); PG8_WAIT_L(0); PG8_BAR; PG8_MMA(1, 0, At, B0); PG8_MMA(1, 1, At, B1); PG8_BAR; PG8_SCHED; \
            } else { \
              \
            PG8_LDB(B0, 0, 0); PG8_SCHED; PG8_LDA(At, 0, 0); PG8_STAGE(PG8_SA(1, 1), a1 + hstepA, PG8_VA1); \
            PG8_WAIT_L(8); PG8_BAR; PG8_WAIT_L(0); PG8_MMA(0, 0, At, B0); PG8_BAR; PG8_SCHED; \
              \
            PG8_LDB(B1, 0, 1); PG8_STAGEB(PG8_SB(0, 0), b2, voffB); \
            PG8_BAR; PG8_WAIT_L(0); PG8_MMA(0, 1, At, B1); PG8_BAR; \
              \
            PG8_LDA(At, 0, 1); PG8_STAGE(PG8_SA(0, 0), a2, s0); \
            PG8_BAR; PG8_WAIT_L(0); PG8_MMA(1, 0, At, B0); PG8_BAR; PG8_SCHED; \
              \
            PG8_STAGEB(PG8_SB(0, 1), b2 + hstep, voffB); \
            PG8_WAIT_V(6); PG8_BAR; PG8_MMA(1, 1, At, B1); PG8_BAR; \
              \
            PG8_LDB(B0, 1, 0); PG8_SCHED; PG8_LDA(At, 1, 0); PG8_STAGE(PG8_SA(0, 1), a2 + hstepA, s1); \
            PG8_WAIT_L(8); PG8_BAR; PG8_WAIT_L(0); PG8_MMA(0, 0, At, B0); PG8_BAR; PG8_SCHED; \
              \
            PG8_LDB(B1, 1, 1); PG8_STAGEB(PG8_SB(1, 0), b3, voffB); \
            PG8_BAR; PG8_WAIT_L(0); PG8_MMA(0, 1, At, B1); PG8_BAR; \
              \
            PG8_LDA(At, 1, 1); PG8_STAGE(PG8_SA(1, 0), a3, s0); \
            PG8_BAR; PG8_WAIT_L(0); PG8_MMA(1, 0, At, B0); PG8_BAR; PG8_SCHED; \
              \
            PG8_STAGEB(PG8_SB(1, 1), b3 + hstep, voffB); \
            PG8_WAIT_V(6); PG8_BAR; PG8_MMA(1, 1, At, B1); PG8_BAR; \
            } \
        } while (0)
#define PG8_WV8() PG8_WAIT_V(8)
#define PG8_ST11_DO(a1_) PG8_STAGE(PG8_SA(1, 1), (a1_) + hstepA, PG8_VA1)
#define PG8_ST11_NONE(a1_) do { } while (0)
#define PG8_WV16() PG8_WAIT_V(16)
#define PG8_WV24() PG8_WAIT_V(24)
        { int t0_ = 0;
          if constexpr (SP2 && ALIGN_EPI && Epi::NST == 16) { if (ui > 0) { PG8_TRIP(0, PG8_WV24, PG8_ST11_NONE, PG8_WV24); t0_ = 2; } }
          if constexpr (SP2 && ALIGN_EPI && Epi::NST == 8 && F8 != 1) { if (ui > 0) { PG8_TRIP(0, PG8_WV16, PG8_ST11_NONE, PG8_WV16); t0_ = 2; } }
          _Pragma("nounroll") for (int t = t0_; t < nt; t += 2) PG8_TRIP(t, PG8_WV8, PG8_ST11_DO, PG8_WV8); }
#undef PG8_WV8
#undef PG8_WV16
#undef PG8_WV24
#undef PG8_TRIP
        if constexpr (ALIGN_EPI) { if (wr == 0) PG8_BAR; }
        if constexpr (SP2 && ALIGN_EPI && Epi::NST > 0 && F8 != 1) { if (has_next) PG8_STAGE(PG8_SA(1, 1), nA + kstep + hstepA, (GATHER ? gN1 : voffA)); }
        if constexpr (F8 == 2) asm volatile("s_nop 15\n\ts_nop 15\n\ts_nop 15" ::: "memory");
        if constexpr (!Epi::AFTER_DRAIN) { int le_; asm volatile("v_mbcnt_lo_u32_b32 %0, -1, 0\n\tv_mbcnt_hi_u32_b32 %0, -1, %0" : "=v"(le_));
            E(acc, cur, wr, wc, le_ & 15, le_ >> 4); S.done(cur); }
        if (!has_next) break;
#pragma unroll
        for (int a = 0; a < 2; ++a)
#pragma unroll
            for (int b = 0; b < 2; ++b)
#pragma unroll
                for (int m = 0; m < 4; ++m)
#pragma unroll
                    for (int n = 0; n < 2; ++n) acc[a][b][m][n] = (f32x4){0.f, 0.f, 0.f, 0.f};
        cur = nxt; cA = nA; cB = nB; ++ui;
        if constexpr (GATHER) { gA0[0] = gN0[0]; gA0[1] = gN0[1]; gA1[0] = gN1[0]; gA1[1] = gN1[1]; }
        if constexpr (ALIGN_EPI) { if (wr == 1) PG8_BAR; }
    }
    PG8_WAIT_V(0);
    if constexpr (!ALIGN_EPI) { if (wr == 0) PG8_BAR; }
    PG8_BAR;
    if constexpr (Epi::AFTER_DRAIN) { E.fused(acc, cur, wr, wc, fr, fq, lds, wid, lane); S.done(cur); }
#undef PG8_SA
#undef PG8_GLOAD
#undef PG8_VA0
#undef PG8_VA1
#undef PG8_SB
#undef PG8_STAGE
#undef PG8_STAGEB
#undef PG8_LDA
#undef PG8_LDB
#undef PG8_MMA
#undef PG8_WAIT_V
#undef PG8_WAIT_L
#undef PG8_BAR
#undef PG8_SCHED
}
}
#define GAS __attribute__((address_space(1)))
#define LAS __attribute__((address_space(3)))
typedef unsigned short bf16;
typedef unsigned v4u __attribute__((ext_vector_type(4)));
typedef float f32x4 __attribute__((ext_vector_type(4)));
typedef short bf16x8 __attribute__((ext_vector_type(8)));
typedef GAS unsigned gu32;
typedef GAS unsigned long long gu64;
#define RLX_AGENT __ATOMIC_RELAXED, __HIP_MEMORY_SCOPE_AGENT
#define LDS_WAIT() asm volatile("s_waitcnt lgkmcnt(0)" ::: "memory")
#define VM_WAIT() asm volatile("s_waitcnt vmcnt(0)" ::: "memory")
__device__ __forceinline__ unsigned long long rt() { return __builtin_amdgcn_s_memrealtime(); }
__device__ __forceinline__ unsigned f2bf(float f) { unsigned u = __builtin_bit_cast(unsigned, f); return (u + 0x7fffu + ((u >> 16) & 1u)) >> 16; }
__device__ __forceinline__ unsigned pk2(float lo, float hi) { return f2bf(lo) | (f2bf(hi) << 16); }
#define XB_TMO      128
#define XB_XCNT(j)  (256  + 64 * (j))
#define XB_XSUB(j)  (1280 + 64 * (j))
#define XB_XGEN(j)  (2304 + 64 * (j))
#define XB_TOP      3328
#define XB_TOPGEN   3392
#define XCD_BAR_WORDS 3456
#define XB_SPIN_CAP (1u << 18)

__device__ __forceinline__ unsigned xb_ld(unsigned* p)              { return __hip_atomic_load(p, __ATOMIC_RELAXED, __HIP_MEMORY_SCOPE_AGENT); }
__device__ __forceinline__ unsigned xb_add(unsigned* p, unsigned v) { return __hip_atomic_fetch_add(p, v, __ATOMIC_RELAXED, __HIP_MEMORY_SCOPE_AGENT); }
__device__ __forceinline__ unsigned xb_xcc_id() { return (unsigned)__builtin_amdgcn_s_getreg((3 << 11) | 20) & 0xFu; }
#define XB_SPIN(cond, bar) do { unsigned _sp = 0; while (cond) { __builtin_amdgcn_s_sleep(1); \
    if ((++_sp & 255u) == 0u) { if (xb_ld(&(bar)[XB_TMO])) break; if (_sp > XB_SPIN_CAP) { atomicAdd(&(bar)[XB_TMO], 1u); break; } } } } while (0)

struct XcdBarrier {
    unsigned* bar; unsigned x;
    volatile LAS unsigned* st;
    int w;
};

__device__ __forceinline__ XcdBarrier xcd_barrier_post(unsigned* bar, volatile LAS unsigned* st) {
    XcdBarrier b; b.bar = bar; b.x = xb_xcc_id(); b.st = st; b.w = __builtin_amdgcn_readfirstlane((int)threadIdx.x >> 6);
    if (threadIdx.x == 0) (void)xb_add(&bar[XB_XCNT(b.x)], 1u);
    return b;
}
__device__ __forceinline__ void xcd_barrier_complete(unsigned* bar, unsigned x, unsigned& nloc, unsigned& nx) {
    const unsigned G = gridDim.x * gridDim.y * gridDim.z;
    unsigned sum, cnt, mine, sp = 0u;
    for (;;) {
        sum = 0u; cnt = 0u; mine = 0u;
#pragma unroll
        for (unsigned j = 0; j < 16; ++j) { const unsigned c = xb_ld(&bar[XB_XCNT(j)]); sum += c; cnt += (c > 0u) ? 1u : 0u; mine = (j == x) ? c : mine; }
        if (sum == G) break;
        __builtin_amdgcn_s_sleep(1);
        if ((++sp & 255u) == 0u) { if (xb_ld(&bar[XB_TMO])) break; if (sp > XB_SPIN_CAP) { atomicAdd(&bar[XB_TMO], 1u); break; } }
    }
    nloc = mine > 0u ? mine : 1u; nx = cnt > 0u ? cnt : 1u;
}

__device__ __forceinline__ void xcd_barrier(const XcdBarrier& b) {
    asm volatile("s_waitcnt vmcnt(0)" ::: "memory");
    __syncthreads();
    int xl_; asm volatile("v_mbcnt_lo_u32_b32 %0, -1, 0\n\tv_mbcnt_hi_u32_b32 %0, -1, %0" : "=v"(xl_));
    if (b.w == 0 && xl_ == 0) {
        unsigned* bar = b.bar;
        __builtin_amdgcn_s_waitcnt(0);
        unsigned nloc = b.st[0], nx = b.st[1];
        if (nloc == 0u) { xcd_barrier_complete(bar, b.x, nloc, nx); b.st[0] = nloc; b.st[1] = nx; }
        const unsigned old = xb_add(&bar[XB_XSUB(b.x)], 1u);
        const unsigned gen = old / nloc;
        if (old + 1u == (gen + 1u) * nloc) {
            __builtin_amdgcn_fence(__ATOMIC_RELEASE, "agent");
            asm volatile("s_waitcnt vmcnt(0)" ::: "memory");
            const unsigned og = xb_add(&bar[XB_TOP], 1u);
            const unsigned tg = og / nx;
            if (og + 1u == (tg + 1u) * nx) xb_add(&bar[XB_TOPGEN], 1u);
            else XB_SPIN(xb_ld(&bar[XB_TOPGEN]) == tg, bar);
            __builtin_amdgcn_fence(__ATOMIC_ACQUIRE, "agent");
            xb_add(&bar[XB_XGEN(b.x)], 1u);
            asm volatile("s_waitcnt vmcnt(0)" ::: "memory");
        } else {
            XB_SPIN(xb_ld(&bar[XB_XGEN(b.x)]) == gen, bar);
            __builtin_amdgcn_fence(__ATOMIC_ACQUIRE, "agent");
            asm volatile("s_waitcnt vmcnt(0)" ::: "memory");
        }
    }
    __syncthreads();
}

constexpr int BATCH = 2, SEQ = 8192, D = 1024, DEPTH = 4, M = BATCH * SEQ;
constexpr int NHEAD = 8, NIN = 7168, NE = 16, FF = 2048, CAP = 1024, NSEL = BATCH * NE * CAP;
constexpr float NORM_EPS = 1e-6f;
constexpr float C2 = 0.125f * 1.4426950408889634f;

template <int MSK> __device__ __forceinline__ float xl_xor(float x) { static_assert(MSK < 32, "xl_xor: within 32 lanes"); return __int_as_float(__builtin_amdgcn_ds_swizzle(__float_as_int(x), (MSK << 10) | 0x1f)); }
__device__ __forceinline__ float xl_add32(float x) { auto rr = __builtin_amdgcn_permlane32_swap(__float_as_uint(x), __float_as_uint(x), false, false); return __uint_as_float(rr[0]) + __uint_as_float(rr[1]); }
__device__ __forceinline__ float xl_max32(float x) { auto rr = __builtin_amdgcn_permlane32_swap(__float_as_uint(x), __float_as_uint(x), false, false); return fmaxf(__uint_as_float(rr[0]), __uint_as_float(rr[1])); }
__device__ __forceinline__ unsigned xl_idx(unsigned v, int src_lane) { return (unsigned)__builtin_amdgcn_ds_bpermute(src_lane << 2, (int)v); }
namespace pg8 {
__device__ __forceinline__ float bf_lo(unsigned w) { return __builtin_bit_cast(float, w << 16); }
__device__ __forceinline__ float bf_hi(unsigned w) { return __builtin_bit_cast(float, w & 0xffff0000u); }
__device__ __forceinline__ float sigmoidf_(float x) { return __builtin_amdgcn_rcpf(1.0f + __builtin_amdgcn_exp2f(-1.4426950408889634f * x)); }

struct EpiIn {
    static constexpr bool PERM = true, AFTER_DRAIN = false; static constexpr int NST = 16;
    bf16_t* O; float* KN2; int roff; float wsc;
    template <int ACT> __device__ __forceinline__ void tile(const f32x4 (&acc)[2][2][4][2], bf16_t* base, int row0, int col0, float sc) const {
#pragma unroll
        for (int ai = 0; ai < 2; ++ai)
#pragma unroll
            for (int m = 0; m < 4; ++m) { bf16_t* rowp = base + (size_t)(row0 + ai * HALF + m * 16) * 1024 + col0;
#pragma unroll
                for (int bj = 0; bj < 2; ++bj) { f32x4 v0 = acc[ai][bj][m][0] * sc, v1 = acc[ai][bj][m][1] * sc;
                    if (ACT == 1) { f32x2 a = gelu_pk((f32x2){v0[0], v0[1]}), b = gelu_pk((f32x2){v0[2], v0[3]}), c = gelu_pk((f32x2){v1[0], v1[1]}), d = gelu_pk((f32x2){v1[2], v1[3]});
                        v0 = (f32x4){a.x, a.y, b.x, b.y}; v1 = (f32x4){c.x, c.y, d.x, d.y}; }
                    else if (ACT == 2) { v0 = (f32x4){sigmoidf_(v0[0]), sigmoidf_(v0[1]), sigmoidf_(v0[2]), sigmoidf_(v0[3])}; v1 = (f32x4){sigmoidf_(v1[0]), sigmoidf_(v1[1]), sigmoidf_(v1[2]), sigmoidf_(v1[3])}; }
                    u32x4 w; w.x = cvt_pk_bf16(v0[0], v0[1]); w.y = cvt_pk_bf16(v0[2], v0[3]); w.z = cvt_pk_bf16(v1[0], v1[1]); w.w = cvt_pk_bf16(v1[2], v1[3]);
                    *(u32x4*)(rowp + bj * HALF) = w; } }
    }
    __device__ __forceinline__ void operator()(const f32x4 (&acc)[2][2][4][2], const Unit& u, int wr, int wc, int fr, int fq) const {
        const int region = (u.pn >> 2) + roff, colt = (u.pn & 3) * BM;
        bf16_t* base = O + (size_t)region * ((size_t)M * 1024);
        const int row0 = u.pm * BM + wr * 64 + fr, col0 = colt + wc * 32 + 8 * fq;
        if (region < 3) { tile<0>(acc, base, row0, col0, region == 0 ? C2 : wsc);
        if (region == 1 && KN2 != nullptr) {
#pragma unroll
            for (int ai = 0; ai < 2; ++ai)
#pragma unroll
                for (int m = 0; m < 4; ++m)
#pragma unroll
                    for (int bj = 0; bj < 2; ++bj) { float ss = 0.f;
#pragma unroll
                        for (int n = 0; n < 2; ++n)
#pragma unroll
                            for (int q = 0; q < 4; ++q) { const float x = __builtin_bit_cast(float, (unsigned)(__builtin_bit_cast(unsigned, acc[ai][bj][m][n][q]) + 0x8000u) & 0xffff0000u); ss = __builtin_fmaf(x, x, ss); }
                        ss += xl_xor<16>(ss); ss = xl_add32(ss);
                        if (fq == 0) __hip_atomic_fetch_add(KN2 + (size_t)((colt + bj * HALF + wc * 32) >> 6) * M + (row0 + ai * HALF + m * 16), ss, __ATOMIC_RELAXED, __HIP_MEMORY_SCOPE_AGENT); }
        } }
        else if (region < 5) tile<1>(acc, base, row0, col0, wsc);
        else tile<2>(acc, base, row0, col0, wsc);
    }
};

template <bool ADD> struct EpiGate {
    static constexpr bool PERM = true, AFTER_DRAIN = false; static constexpr int NST = 0;
    const bf16_t* G; bf16_t* O;
    __device__ __forceinline__ void operator()(const f32x4 (&acc)[2][2][4][2], const Unit& u, int wr, int wc, int fr, int fq) const {
        const int row0 = u.pm * BM + wr * 64 + fr, col0 = u.pn * BM + wc * 32 + 8 * fq;
#pragma unroll
        for (int ai = 0; ai < 2; ++ai)
#pragma unroll
            for (int m = 0; m < 4; ++m) { const size_t off = (size_t)(row0 + ai * HALF + m * 16) * 1024 + col0;
#pragma unroll
                for (int bj = 0; bj < 2; ++bj) { const f32x4 v0 = acc[ai][bj][m][0], v1 = acc[ai][bj][m][1];
                    const u32x4 g = *(const u32x4*)(G + off + bj * HALF);
                    float r0 = v0[0] * bf_lo(g.x), r1 = v0[1] * bf_hi(g.x), r2 = v0[2] * bf_lo(g.y), r3 = v0[3] * bf_hi(g.y);
                    float r4 = v1[0] * bf_lo(g.z), r5 = v1[1] * bf_hi(g.z), r6 = v1[2] * bf_lo(g.w), r7 = v1[3] * bf_hi(g.w);
                    if (ADD) { const u32x4 p = *(const u32x4*)(O + off + bj * HALF);
                        r0 += bf_lo(p.x); r1 += bf_hi(p.x); r2 += bf_lo(p.y); r3 += bf_hi(p.y); r4 += bf_lo(p.z); r5 += bf_hi(p.z); r6 += bf_lo(p.w); r7 += bf_hi(p.w); }
                    u32x4 w; w.x = cvt_pk_bf16(r0, r1); w.y = cvt_pk_bf16(r2, r3); w.z = cvt_pk_bf16(r4, r5); w.w = cvt_pk_bf16(r6, r7);
                    *(u32x4*)(O + off + bj * HALF) = w; } }
    }
};

struct EpiGate2 {
    static constexpr bool PERM = true, AFTER_DRAIN = false; static constexpr int NST = 0;
    const bf16_t* G0; bf16_t* O;
    __device__ __forceinline__ void operator()(const f32x4 (&acc)[2][2][4][2], const Unit& u, int wr, int wc, int fr, int fq) const {
        const int which = u.pm >> 6; Unit v; v.pm = u.pm & 63; v.pn = u.pn & 3;
        if (which) { EpiGate<true> e{G0 + (size_t)M * 1024, O}; e(acc, v, wr, wc, fr, fq); } else { EpiGate<false> e{G0, O}; e(acc, v, wr, wc, fr, fq); }
    }
};
struct AbOrder { StaticOrder S;
    __device__ __forceinline__ bool next(int i, Unit& u) const { if (i >= 2) return false; if (!S.next(0, u)) return false; if (i == 1) { u.pm += 64; u.pn += 4; } return true; }
    __device__ __forceinline__ void a_ready(const Unit&) const {}
    __device__ __forceinline__ void done(const Unit&) const {}
};

struct EpiYb {
    static constexpr bool PERM = true, AFTER_DRAIN = false; static constexpr int NST = 0;
    bf16_t* O;
    __device__ __forceinline__ void operator()(const f32x4 (&acc)[2][2][4][2], const Unit& u, int wr, int wc, int fr, int fq) const {
        const EpiIn e{O, nullptr, 0, 1.0f}; e.template tile<0>(acc, O, u.pm * BM + wr * 64 + fr, u.pn * BM + wc * 32 + 8 * fq, 1.0f);
    }
};
struct EpiF32 {
    static constexpr bool PERM = false, AFTER_DRAIN = false; static constexpr int NST = 0;
    float* O;
    __device__ __forceinline__ void operator()(const f32x4 (&acc)[2][2][4][2], const Unit& u, int wr, int wc, int fr, int fq) const {
        const int row0 = u.pm * BM + wr * 64 + fr, col0 = u.pn * BM + wc * 32 + 4 * fq;
#pragma unroll
        for (int ai = 0; ai < 2; ++ai)
#pragma unroll
            for (int m = 0; m < 4; ++m) { float* rowp = O + (size_t)(row0 + ai * HALF + m * 16) * 1024 + col0;
#pragma unroll
                for (int bj = 0; bj < 2; ++bj)
#pragma unroll
                    for (int n = 0; n < 2; ++n) *(f32x4*)(rowp + bj * HALF + n * 16) = acc[ai][bj][m][n]; }
    }
};

__device__ __forceinline__ float f8clamp(float x) { return __builtin_fminf(__builtin_fmaxf(x, -448.0f), 448.0f); }
__device__ __forceinline__ unsigned pk4_fp8(float a, float b, float c, float d) {
    int w = 0; w = __builtin_amdgcn_cvt_pk_fp8_f32(f8clamp(a), f8clamp(b), w, false); w = __builtin_amdgcn_cvt_pk_fp8_f32(f8clamp(c), f8clamp(d), w, true); return (unsigned)w; }
struct EpiMoe1 {
    static constexpr bool PERM = true, AFTER_DRAIN = false; static constexpr int NST = 8;
    unsigned char* O; float wsc;
    __device__ __forceinline__ void operator()(const f32x4 (&acc)[2][2][4][2], const Unit& u, int wr, int wc, int fr, int fq) const {
        const int row0 = u.pm * BM + wr * 64 + fr, col0 = (u.pn & 15) * HALF + wc * 32 + 8 * fq;
#pragma unroll
        for (int ai = 0; ai < 2; ++ai)
#pragma unroll
            for (int m = 0; m < 4; ++m) { unsigned char* rowp = O + (size_t)(row0 + ai * HALF + m * 16) * FF + col0;
                float r[8];
#pragma unroll
                for (int n = 0; n < 2; ++n)
#pragma unroll
                    for (int q = 0; q < 4; ++q) { const float ag = acc[ai][0][m][n][q], au = acc[ai][1][m][n][q];
                        r[n * 4 + q] = (ag * au) * ((wsc * wsc) * __builtin_amdgcn_rcpf(1.0f + __builtin_amdgcn_exp2f(ag * (-1.4426950408889634f * wsc)))); }
                typedef unsigned u32x2_ __attribute__((ext_vector_type(2)));
                u32x2_ w; w.x = pk4_fp8(r[0], r[1], r[2], r[3]); w.y = pk4_fp8(r[4], r[5], r[6], r[7]);
                *(u32x2_*)rowp = w; }
    }
};

struct EpiMoe2 {
    static constexpr bool PERM = true, AFTER_DRAIN = false; static constexpr int NST = 0;
    bf16_t* O; const float* gate; float wsc;
    __device__ __forceinline__ void operator()(const f32x4 (&acc)[2][2][4][2], const Unit& u, int wr, int wc, int fr, int fq) const {
        const int row0 = u.pm * BM + wr * 64 + fr, col0 = (u.pn & 3) * BM + wc * 32 + 8 * fq;
#pragma unroll
        for (int ai = 0; ai < 2; ++ai)
#pragma unroll
            for (int m = 0; m < 4; ++m) { const int row = row0 + ai * HALF + m * 16; const float gt = gate[row] * wsc; bf16_t* rowp = O + (size_t)row * 1024 + col0;
#pragma unroll
                for (int bj = 0; bj < 2; ++bj) { const f32x4 v0 = acc[ai][bj][m][0] * gt, v1 = acc[ai][bj][m][1] * gt;
                    u32x4 w; w.x = cvt_pk_bf16(v0[0], v0[1]); w.y = cvt_pk_bf16(v0[2], v0[3]); w.z = cvt_pk_bf16(v1[0], v1[1]); w.w = cvt_pk_bf16(v1[2], v1[3]);
                    *(u32x4*)(rowp + bj * HALF) = w; } }
    }
};

struct MoeOrder1 {
    int vcu, G;
    __device__ __forceinline__ bool next(int i, Unit& u) const {
        if (G == 256) { if (i >= 8) return false; const int e = vcu >> 4, c = vcu & 15; u.pm = e * 8 + 4 * (i & 1) + (c & 3); u.pn = e * 16 + 4 * (i >> 1) + (c >> 2); return true; }
        const int id = i * G + vcu; if (id >= NE * 128) return false; const int e = id >> 7, r = id & 127; u.pm = e * 8 + (r & 7); u.pn = e * 16 + (r >> 3); return true;
    }
    __device__ __forceinline__ void a_ready(const Unit&) const {}
    __device__ __forceinline__ void done(const Unit&) const {}
};
struct MoeOrder2 {
    int vcu, G;
    __device__ __forceinline__ bool next(int i, Unit& u) const {
        if (G == 256) { if (i >= 2) return false; const int e = vcu >> 4, c = vcu & 15; u.pm = e * 8 + 4 * i + (c & 3); u.pn = e * 4 + (c >> 2); return true; }
        const int id = i * G + vcu; if (id >= NE * 32) return false; const int e = id >> 5, r = id & 31; u.pm = e * 8 + (r & 7); u.pn = e * 4 + (r >> 3); return true;
    }
    __device__ __forceinline__ void a_ready(const Unit&) const {}
    __device__ __forceinline__ void done(const Unit&) const {}
};
}

namespace att {
using bf16_t = unsigned short;
using bf16x8 = __attribute__((ext_vector_type(8))) short;
using s16x4  = __attribute__((ext_vector_type(4))) short;
using f32x16 = __attribute__((ext_vector_type(16))) float;
using f32x4  = __attribute__((ext_vector_type(4))) float;
using u32x4  = __attribute__((ext_vector_type(4))) unsigned;
constexpr int SHM_V = 64 * 128 * 2, SHM_K = 64 * 64 * 2, OFF_K = 2 * SHM_V, OFF_WS = OFF_K + 4 * SHM_K, OFF_KT = OFF_WS + 8 * 64 * 4, OFF_RED = OFF_KT + 128 * 4, LDS_BYTES = OFF_RED + 64;
constexpr float SKIP_T = 38.0f;
constexpr float DEAD_T = 38.0f;
constexpr float THR2 = 8.0f;
#define ATT_KSWZ(row, colB) ((row) * 128 + ((colB) ^ ((((row) >> 1) & 7) << 4)))
#define ATT_SBAR() __builtin_amdgcn_sched_barrier(0)
__device__ __forceinline__ int lane_id_asm() { int l; asm volatile("v_mbcnt_lo_u32_b32 %0, -1, 0\n\tv_mbcnt_hi_u32_b32 %0, -1, %0" : "=v"(l)); return l; }
__device__ __forceinline__ __amdgpu_buffer_rsrc_t att_rsrc(const void* p) {
  const unsigned long long v = (unsigned long long)p; const unsigned lo = __builtin_amdgcn_readfirstlane((unsigned)v), hi = __builtin_amdgcn_readfirstlane((unsigned)(v >> 32));
  return __builtin_amdgcn_make_buffer_rsrc((void*)(((unsigned long long)hi << 32) | lo), 0, 0x7ffffff0, 0x00020000); }
template <int MSK> __device__ __forceinline__ float swz_xor(float x) { return __int_as_float(__builtin_amdgcn_ds_swizzle(__float_as_int(x), (MSK << 10) | 0x1f)); }
template <int CTRL> __device__ __forceinline__ float dpp_mov(float x) { return __int_as_float(__builtin_amdgcn_update_dpp(0, __float_as_int(x), CTRL, 0xf, 0xf, true)); }
__device__ __forceinline__ float row16_sum(float v) { v += dpp_mov<0xB1>(v); v += dpp_mov<0x4E>(v); v += dpp_mov<0x141>(v); v += dpp_mov<0x140>(v); return v; }
__device__ __forceinline__ int crow(int r, int hi) { return (r & 3) + 8 * (r >> 2) + 4 * hi; }
typedef float f32x2a_t __attribute__((ext_vector_type(2))); typedef __bf16 bf16x2a_t __attribute__((ext_vector_type(2)));
__device__ __forceinline__ unsigned cvtpk(float lo, float hi) { f32x2a_t v = {lo, hi}; bf16x2a_t b = __builtin_convertvector(v, bf16x2a_t); return __builtin_bit_cast(unsigned, b); }

__device__ __forceinline__ int v_st(int k, int c) { const int kk = (k & ~0xC) | ((k & 4) << 1) | ((k & 8) >> 1); return ((kk >> 3) * 4 + (c >> 5)) * 512 + ((kk & 7) * 32 + (c & 31)) * 2; }
__device__ __forceinline__ int v_rd_base(int lane) { return ((lane & 3) << 3) | (((lane >> 2) & 3) << 6) | (((lane >> 4) & 1) << 5) | (((lane >> 5) & 1) << 8); }
constexpr int v_rd_off(int d0, int ks, int half) { return d0 * 512 + ks * 4096 + half * 2048; }
template <int OFF> __device__ __forceinline__ s16x4 tr_read(int vb) {
  s16x4 r; asm volatile("ds_read_b64_tr_b16 %0, %1 offset:%2" : "=&v"(r) : "v"(vb), "i"(OFF) : "memory"); return r;
}
template <int OFF> __device__ __forceinline__ bf16x8 k_read(int ka) {
  bf16x8 r; asm volatile("ds_read_b128 %0, %1 offset:%2" : "=&v"(r) : "v"(ka), "i"(OFF) : "memory"); return r;
}
template <int D0, int BOFF = 0> __device__ __forceinline__ void pv_one(f32x16& od, int vb, bf16x8 pa0, bf16x8 pa1, bf16x8 pa2, bf16x8 pa3) {
  const s16x4 l0 = tr_read<BOFF + v_rd_off(D0, 0, 0)>(vb), h0 = tr_read<BOFF + v_rd_off(D0, 0, 1)>(vb), l1 = tr_read<BOFF + v_rd_off(D0, 1, 0)>(vb), h1 = tr_read<BOFF + v_rd_off(D0, 1, 1)>(vb);
  const s16x4 l2 = tr_read<BOFF + v_rd_off(D0, 2, 0)>(vb), h2 = tr_read<BOFF + v_rd_off(D0, 2, 1)>(vb), l3 = tr_read<BOFF + v_rd_off(D0, 3, 0)>(vb), h3 = tr_read<BOFF + v_rd_off(D0, 3, 1)>(vb);
  asm volatile("s_waitcnt lgkmcnt(0)" ::: "memory"); ATT_SBAR();
#define ATT_PK(L, H) (bf16x8){L[0], L[1], L[2], L[3], H[0], H[1], H[2], H[3]}
  od = __builtin_amdgcn_mfma_f32_32x32x16_bf16(pa0, ATT_PK(l0, h0), od, 0, 0, 0);
  od = __builtin_amdgcn_mfma_f32_32x32x16_bf16(pa1, ATT_PK(l1, h1), od, 0, 0, 0);
  od = __builtin_amdgcn_mfma_f32_32x32x16_bf16(pa2, ATT_PK(l2, h2), od, 0, 0, 0);
  od = __builtin_amdgcn_mfma_f32_32x32x16_bf16(pa3, ATT_PK(l3, h3), od, 0, 0, 0);
#undef ATT_PK
}
template <int BOFF = 0> __device__ __forceinline__ void pv_d0(f32x16* o, int vb, bf16x8 pa0, bf16x8 pa1, bf16x8 pa2, bf16x8 pa3) {
  pv_one<0, BOFF>(o[0], vb, pa0, pa1, pa2, pa3); pv_one<1, BOFF>(o[1], vb, pa0, pa1, pa2, pa3); pv_one<2, BOFF>(o[2], vb, pa0, pa1, pa2, pa3); pv_one<3, BOFF>(o[3], vb, pa0, pa1, pa2, pa3);
}

template <int BOFF> __device__ __forceinline__ void qkt(f32x16& p0, f32x16& p1, const int (&ka4)[4], const bf16x8* qr, int r32, int hi, float dq, float nsl2, float negm, int side) {
  if (side == 0) {
#pragma unroll
    for (int r = 0; r < 16; ++r) { const float t0 = dq + (float)((r & 3) + 8 * (r >> 2)); p0[r] = __builtin_fmaf(nsl2, __builtin_fabsf(t0), negm); p1[r] = __builtin_fmaf(nsl2, __builtin_fabsf(t0 + 32.0f), negm); }
  } else {
    const float s = side < 0 ? -nsl2 : nsl2;
    const float b0 = __builtin_fmaf(s, dq, negm), b1 = __builtin_fmaf(s, 32.0f, b0);
#pragma unroll
    for (int r = 0; r < 16; ++r) { const float cr = (float)((r & 3) + 8 * (r >> 2)); p0[r] = __builtin_fmaf(s, cr, b0); p1[r] = __builtin_fmaf(s, cr, b1); }
  }
  bf16x8 kf[8];
  {
#pragma unroll
    for (int d0 = 0; d0 < 4; ++d0) { kf[2 * d0] = k_read<BOFF>(ka4[d0]); kf[2 * d0 + 1] = k_read<BOFF + 4096>(ka4[d0]); }
    asm volatile("s_waitcnt lgkmcnt(0)" ::: "memory"); ATT_SBAR(); }
#pragma unroll
  for (int d0 = 0; d0 < 4; ++d0) {
    p0 = __builtin_amdgcn_mfma_f32_32x32x16_bf16(kf[2 * d0], qr[d0], p0, 0, 0, 0);
    p1 = __builtin_amdgcn_mfma_f32_32x32x16_bf16(kf[2 * d0 + 1], qr[d0], p1, 0, 0, 0); }
}
template <bool FIRST> __device__ __forceinline__ bool partialSM(f32x16& p0, f32x16& p1, float& m_ref, float& alpha) {
  float pmax = p0[0];
#pragma unroll
  for (int r = 1; r < 16; ++r) pmax = fmaxf(pmax, p0[r]);
#pragma unroll
  for (int r = 0; r < 16; ++r) pmax = fmaxf(pmax, p1[r]);
  { auto rr = __builtin_amdgcn_permlane32_swap(__float_as_uint(pmax), __float_as_uint(pmax), false, false);
    pmax = fmaxf(__uint_as_float(rr[0]), __uint_as_float(rr[1])); }
  alpha = 1.f;
  if (!FIRST && __all(pmax < -DEAD_T)) return true;
  if (FIRST || !__all(pmax <= THR2)) {
    const float dl = FIRST ? pmax : fmaxf(pmax, 0.f);
    if (!FIRST) alpha = __builtin_amdgcn_exp2f(-dl);
    m_ref += dl;
#pragma unroll
    for (int r = 0; r < 16; ++r) { p0[r] -= dl; p1[r] -= dl; }
  }
#pragma unroll
  for (int r = 0; r < 16; ++r) p0[r] = __builtin_amdgcn_exp2f(p0[r]);
  return false;
}
__device__ __forceinline__ void finishSM(f32x16& p0, f32x16& p1, float alpha, float& l_reg, bf16x8& pa0, bf16x8& pa1, bf16x8& pa2, bf16x8& pa3) {
#pragma unroll
  for (int r = 0; r < 16; ++r) p1[r] = __builtin_amdgcn_exp2f(p1[r]);
  float ps = 0;
#pragma unroll
  for (int r = 0; r < 16; ++r) ps += p0[r];
#pragma unroll
  for (int r = 0; r < 16; ++r) ps += p1[r];
  { auto rr = __builtin_amdgcn_permlane32_swap(__float_as_uint(ps), __float_as_uint(ps), false, false);
    ps = __uint_as_float(rr[0]) + __uint_as_float(rr[1]); }
  l_reg = l_reg * alpha + ps;
#define ATT_PK4(P, BASE, OUT) do { unsigned a0 = cvtpk(P[BASE + 0], P[BASE + 1]), a1 = cvtpk(P[BASE + 2], P[BASE + 3]);   \
    unsigned b0 = cvtpk(P[BASE + 4], P[BASE + 5]), b1 = cvtpk(P[BASE + 6], P[BASE + 7]);                              \
    auto r0 = __builtin_amdgcn_permlane32_swap(a0, b0, false, false); auto r1 = __builtin_amdgcn_permlane32_swap(a1, b1, false, false); \
    u32x4 w = {r0[0], r1[0], r0[1], r1[1]}; OUT = *reinterpret_cast<bf16x8*>(&w); } while (0)
  ATT_PK4(p0, 0, pa0); ATT_PK4(p0, 8, pa1); ATT_PK4(p1, 0, pa2); ATT_PK4(p1, 8, pa3);
#undef ATT_PK4
}

__device__ __forceinline__ void attn_unit(int b, int h, int qb, const bf16_t* __restrict__ QB, const bf16_t* __restrict__ KB, const bf16_t* __restrict__ VB,
                                          bf16_t* __restrict__ OB, const float* __restrict__ KN2, float lam, float onemli, const float* __restrict__ gsub, char* lds, int wid) {
  const int lane = lane_id_asm(), tid = wid * 64 + lane, r32 = lane & 31, hi = lane >> 5;
  const int n = wid >> 2, wq = wid & 3;
  char* V_lds = lds; char* K_lds = lds + OFF_K;
  float* ws = (float*)(lds + OFF_WS) + wid * 64; float* li_l = ws; float* al_l = ws + 32;
  float* KT = (float*)(lds + OFF_KT); float* red = (float*)(lds + OFF_RED);
  const float nsl2 = -__builtin_amdgcn_exp2f(-(float)(h + 1)) * 1.4426950408889634f;
  const float sl2 = -nsl2;
  const int q0 = qb * 128, qp = q0 + wq * 32 + r32, jd = (q0 + wq * 32) >> 6;
  const size_t rowbase = (size_t)b * SEQ;
  const bf16_t* Vh = VB + rowbase * 1024 + h * 128;
  const bf16_t* Kh = KB + rowbase * 1024 + h * 64;
  const int kr = tid >> 3, kc = (tid & 7) * 8, sr = tid >> 4, sc = (tid & 15) * 8;
  const int kst = ATT_KSWZ(kr, kc * 2), vst0 = v_st(sr, sc), vst1 = v_st(32 + sr, sc);
  const int vb0 = (int)(uintptr_t)V_lds + v_rd_base(lane);
  const float dqn = (float)(4 * hi - qp);
  struct { bf16x8 vs0, vs1, k0, k1; } sr_[1];
  const __amdgpu_buffer_rsrc_t rsV_ = att_rsrc(Vh), rsK_ = att_rsrc(Kh);
  const int voV_ = (sr * 1024 + sc) * 2, voK_ = (kr * 1024 + kc) * 2;
#define ATT_SLOAD(i, kk0) do { const int so_ = (kk0) * 2048; \
    sr_[i].vs0 = __builtin_bit_cast(bf16x8, __builtin_amdgcn_raw_buffer_load_b128(rsV_, voV_, so_, 0)); sr_[i].vs1 = __builtin_bit_cast(bf16x8, __builtin_amdgcn_raw_buffer_load_b128(rsV_, voV_, so_ + 32 * 2048, 0)); \
    sr_[i].k0 = __builtin_bit_cast(bf16x8, __builtin_amdgcn_raw_buffer_load_b128(rsK_, voK_, so_, 0)); sr_[i].k1 = __builtin_bit_cast(bf16x8, __builtin_amdgcn_raw_buffer_load_b128(rsK_, voK_ + 1024, so_, 0)); } while (0)
#define ATT_SWRITE(bb, i) do { *(bf16x8*)(V_lds + (bb) * SHM_V + vst0) = sr_[i].vs0; *(bf16x8*)(V_lds + (bb) * SHM_V + vst1) = sr_[i].vs1; \
    *(bf16x8*)(K_lds + ((bb) * 2) * SHM_K + kst) = sr_[i].k0; *(bf16x8*)(K_lds + ((bb) * 2 + 1) * SHM_K + kst) = sr_[i].k1; } while (0)
#define ATT_SWAIT() asm volatile("s_waitcnt vmcnt(0)" ::: "memory")
  const int c0 = q0 >> 6;
  ATT_SLOAD(0, c0 * 64);
  bf16x8 qr[4];
  { const bf16_t* Qw = QB + (rowbase + qp) * 1024 + n * 512 + h * 64 + hi * 8;
#pragma unroll
    for (int d0 = 0; d0 < 4; ++d0) qr[d0] = *reinterpret_cast<const bf16x8*>(Qw + d0 * 16); }
  int jlo, NT; float qm_u;
  { f32x4 kna[4], knc[4];
    { const float* kn = KN2 + (size_t)h * M + rowbase + (tid >> 2) * 64 + (tid & 3) * 16;
#pragma unroll
      for (int i = 0; i < 4; ++i) { kna[i] = *reinterpret_cast<const f32x4*>(kn + 4 * i); knc[i] = *reinterpret_cast<const f32x4*>(kn + (size_t)8 * M + 4 * i); } }
    float qs = 0.f;
#pragma unroll
    for (int d0 = 0; d0 < 4; ++d0)
#pragma unroll
      for (int e = 0; e < 8; ++e) { const float x = __builtin_bit_cast(float, (unsigned)(unsigned short)qr[d0][e] << 16); qs = __builtin_fmaf(x, x, qs); }
    { auto rr = __builtin_amdgcn_permlane32_swap(__float_as_uint(qs), __float_as_uint(qs), false, false); qs = __uint_as_float(rr[0]) + __uint_as_float(rr[1]); }
    qs = fmaxf(qs, swz_xor<1>(qs)); qs = fmaxf(qs, swz_xor<2>(qs)); qs = fmaxf(qs, swz_xor<4>(qs)); qs = fmaxf(qs, swz_xor<8>(qs)); qs = fmaxf(qs, swz_xor<16>(qs));
    if (lane == 0) red[wid] = qs;
    ATT_SWRITE(0, 0); ATT_SLOAD(0, (c0 + 1) * 64);
    { const int tile = tid >> 2, part = tid & 3; float km = 0.f;
#pragma unroll
      for (int i = 0; i < 4; ++i) { const f32x4 a = kna[i], c = knc[i];
        km = fmaxf(fmaxf(km, fmaxf(fmaxf(a[0], a[1]), fmaxf(a[2], a[3]))), fmaxf(fmaxf(c[0], c[1]), fmaxf(c[2], c[3]))); }
      km = fmaxf(km, swz_xor<1>(km)); km = fmaxf(km, swz_xor<2>(km));
      if (part == 0) KT[tile] = __builtin_sqrtf(km); }
    __syncthreads();
    float qm = red[0];
#pragma unroll
    for (int w = 1; w < 8; ++w) qm = fmaxf(qm, red[w]);
    qm = __builtin_sqrtf(qm) * 1.002f; qm_u = qm;
    const int t2 = q0 >> 6; const float kself = fmaxf(KT[t2], KT[t2 + 1]);
    if (tid < 128) { const int j = tid; const int dmin = (64 * j + 63 < q0) ? (q0 - 64 * j - 63) : (64 * j > q0 + 127) ? (64 * j - q0 - 127) : 0;
      const bool need = (dmin == 0) || (qm * (KT[j] + kself) - sl2 * (float)dmin > -SKIP_T);
      const unsigned long long mk = __ballot(need);
      if (lane == 0) ((unsigned long long*)(red + 8))[wid] = mk; }
    __syncthreads();
    const unsigned long long m0 = ((const unsigned long long*)(red + 8))[0], m1 = ((const unsigned long long*)(red + 8))[1];
    int lo_ = m0 ? __builtin_ctzll(m0) : 64 + __builtin_ctzll(m1), hi_ = m1 ? 128 - __builtin_clzll(m1) : 64 - __builtin_clzll(m0);
    if ((hi_ - lo_) & 1) { if (hi_ < 128) ++hi_; else --lo_; }
    jlo = __builtin_amdgcn_readfirstlane(lo_); NT = __builtin_amdgcn_readfirstlane(hi_ - lo_); }
  float m_ref = 0.f, l_reg = 0.f; f32x16 o[4] = {};
#define ATT_RESC(a) do { if (__any((a) < 1.f)) { if (hi == 0) al_l[r32] = (a); asm volatile("s_waitcnt lgkmcnt(0)" ::: "memory"); \
    _Pragma("unroll") for (int d = 0; d < 4; ++d) _Pragma("unroll") for (int r = 0; r < 16; ++r) o[d][r] *= al_l[crow(r, hi)]; } } while (0)
  int nL = c0 - jlo;
#define ATT_TILE(s_) ((s_) < 2 ? c0 + (s_) : ((s_) - 2 < nL ? jlo + ((s_) - 2) : c0 + 2 + ((s_) - 2 - nL)))
#define ATT_SIDE(t) (ATT_TILE(t) < jd ? -1 : ATT_TILE(t) > jd ? 1 : 0)
  f32x16 pA0, pA1, pB0, pB1; float alA, alB; bf16x8 pa0, pa1, pa2, pa3;
  int ka4[4];
#pragma unroll
  for (int d0 = 0; d0 < 4; ++d0) ka4[d0] = (int)(uintptr_t)(K_lds + n * SHM_K) + ATT_KSWZ(r32, d0 * 32 + hi * 16);
  bool deadA = false, deadB = false;
  qkt<0>(pA0, pA1, ka4, qr, r32, hi, dqn + (float)(ATT_TILE(0) * 64), nsl2, 0.f, ATT_SIDE(0)); (void)partialSM<true>(pA0, pA1, m_ref, alA);
  { float mm = m_ref; mm = fminf(mm, swz_xor<1>(mm)); mm = fminf(mm, swz_xor<2>(mm)); mm = fminf(mm, swz_xor<4>(mm)); mm = fminf(mm, swz_xor<8>(mm)); mm = fminf(mm, swz_xor<16>(mm));
    if (lane == 0) red[wid] = mm;
    __syncthreads();
    float mmin = red[0];
#pragma unroll
    for (int w = 1; w < 8; ++w) mmin = fminf(mmin, red[w]);
    if (tid < 128) { const int j = tid; const int dmin = (64 * j + 63 < q0) ? (q0 - 64 * j - 63) : (64 * j > q0 + 127) ? (64 * j - q0 - 127) : 0;
      const bool need = (j >= jlo) && (j < jlo + NT) && ((dmin == 0) || (qm_u * KT[j] - sl2 * (float)dmin - mmin > -SKIP_T));
      const unsigned long long mk = __ballot(need);
      if (lane == 0) ((unsigned long long*)(red + 8))[wid] = mk; }
    __syncthreads();
    const unsigned long long m0 = ((const unsigned long long*)(red + 8))[0], m1 = ((const unsigned long long*)(red + 8))[1];
    int lo_ = m0 ? __builtin_ctzll(m0) : 64 + __builtin_ctzll(m1), hi_ = m1 ? 128 - __builtin_clzll(m1) : 64 - __builtin_clzll(m0);
    if ((hi_ - lo_) & 1) { if (hi_ < 128) ++hi_; else --lo_; }
    jlo = __builtin_amdgcn_readfirstlane(lo_); NT = __builtin_amdgcn_readfirstlane(hi_ - lo_);
    nL = c0 - jlo; }
  ATT_SWAIT(); ATT_SWRITE(1, 0); __syncthreads();
#pragma nounroll
  for (int j = 1; j + 1 < NT; j += 2) {
    const int tj = ATT_TILE(j), tj1 = ATT_TILE(j + 1), tj2 = ATT_TILE(j + 2);
    ATT_SBAR(); qkt<2 * SHM_K>(pB0, pB1, ka4, qr, r32, hi, dqn + (float)(tj * 64), nsl2, -m_ref, tj < jd ? -1 : tj > jd ? 1 : 0);
    if (!deadA) finishSM(pA0, pA1, alA, l_reg, pa0, pa1, pa2, pa3); ATT_SBAR();
    ATT_SLOAD(0, tj1 * 64); ATT_SBAR();
    if (!deadA) pv_d0(o, vb0, pa0, pa1, pa2, pa3); deadB = partialSM<false>(pB0, pB1, m_ref, alB);
    __syncthreads(); ATT_SWAIT(); ATT_SWRITE(0, 0);
    ATT_RESC(alB); __syncthreads();
    ATT_SBAR(); qkt<0>(pA0, pA1, ka4, qr, r32, hi, dqn + (float)(tj1 * 64), nsl2, -m_ref, tj1 < jd ? -1 : tj1 > jd ? 1 : 0);
    if (!deadB) finishSM(pB0, pB1, alB, l_reg, pa0, pa1, pa2, pa3); ATT_SBAR();
    ATT_SLOAD(0, tj2 * 64); ATT_SBAR();
    if (!deadB) pv_d0<SHM_V>(o, vb0, pa0, pa1, pa2, pa3); deadA = partialSM<false>(pA0, pA1, m_ref, alA);
    __syncthreads(); ATT_SWAIT(); ATT_SWRITE(1, 0);
    ATT_RESC(alA); __syncthreads();
  }
  { const int tl = ATT_TILE(NT - 1);
    ATT_SBAR(); qkt<2 * SHM_K>(pB0, pB1, ka4, qr, r32, hi, dqn + (float)(tl * 64), nsl2, -m_ref, tl < jd ? -1 : tl > jd ? 1 : 0); }
  if (!deadA) finishSM(pA0, pA1, alA, l_reg, pa0, pa1, pa2, pa3); ATT_SBAR();
  if (!deadA) pv_d0(o, vb0, pa0, pa1, pa2, pa3); deadB = partialSM<false>(pB0, pB1, m_ref, alB);
  __syncthreads(); ATT_RESC(alB);
  if (!deadB) { finishSM(pB0, pB1, alB, l_reg, pa0, pa1, pa2, pa3); ATT_SBAR();
    pv_d0<SHM_V>(o, vb0, pa0, pa1, pa2, pa3); }
  if (hi == 0) li_l[r32] = l_reg; asm volatile("s_waitcnt lgkmcnt(0)" ::: "memory");
  float rli[16];
#pragma unroll
  for (int r = 0; r < 16; ++r) rli[r] = __builtin_amdgcn_rcpf(li_l[crow(r, hi)]);
  __syncthreads();
  float* xch = (float*)lds + wq * 4096 + lane;
#define ATT_XW(R0) do { _Pragma("unroll") for (int r = (R0); r < (R0) + 8; ++r) _Pragma("unroll") for (int d0 = 0; d0 < 4; ++d0) xch[(d0 * 16 + r) * 64] = o[d0][r] * rli[r]; } while (0)
  if (n == 1) ATT_XW(0); else ATT_XW(8);
#undef ATT_XW
  __syncthreads();
  { int hi_e = hi, r32_e = r32; asm volatile("" : "+v"(hi_e), "+v"(r32_e));
    const unsigned lo_e = (unsigned)(hi_e * 4096 + r32_e);
    bf16_t* const obw = OB + (rowbase + q0 + wq * 32) * 1024 + h * 128;
    float gs[4];
#pragma unroll
    for (int d0 = 0; d0 < 4; ++d0) gs[d0] = gsub[d0 * 32 + r32_e] * onemli;
#define ATT_FIN(R0, MINE_IS_1) do { _Pragma("unroll") for (int r = (R0); r < (R0) + 8; ++r) { const unsigned off = lo_e + (unsigned)(((r & 3) + 8 * (r >> 2)) * 1024); float dv[4]; float ss = 0.f; \
      _Pragma("unroll") for (int d0 = 0; d0 < 4; ++d0) { const float mine = o[d0][r] * rli[r], oth = xch[(d0 * 16 + r) * 64]; dv[d0] = (MINE_IS_1) ? mine - lam * oth : oth - lam * mine; ss += dv[d0] * dv[d0]; } \
      ss = row16_sum(ss); ss += swz_xor<16>(ss); \
      const float rs = __builtin_amdgcn_rsqf(ss * (1.0f / 128.0f) + NORM_EPS); \
      _Pragma("unroll") for (int d0 = 0; d0 < 4; ++d0) obw[off + d0 * 32] = (bf16_t)f2bf(dv[d0] * rs * gs[d0]); \
      if ((r & 3) == 3) asm volatile("" ::: "memory"); } } while (0)
    if (n == 0) ATT_FIN(0, true); else ATT_FIN(8, false);
#undef ATT_FIN
  }
  __syncthreads();
#undef ATT_SLOAD
#undef ATT_SIDE
#undef ATT_TILE
#undef ATT_SWRITE
#undef ATT_SWAIT
#undef ATT_RESC
}
}

constexpr size_t MiB = 1u << 20;
constexpr size_t WS_CTL = 0, CTL_ZERO_BYTES = 1 * MiB;
constexpr size_t WS_MOD = 1 * MiB;
constexpr size_t WS_WSP = 2 * MiB;
constexpr size_t WS_AFF = 3 * MiB;
constexpr size_t WS_SLOT = 4 * MiB;
constexpr size_t WS_IDX = 5 * MiB;
constexpr size_t WS_KN2 = 6 * MiB;
constexpr size_t WS_W = 8 * MiB, W_LAYER = 212 * MiB;
constexpr size_t W_IN = 0, W_A = 14 * MiB, W_B = 16 * MiB, W_O = 18 * MiB, W_GU = 20 * MiB, W_D = 148 * MiB;
constexpr size_t WS_XN = WS_W + DEPTH * W_LAYER;
constexpr size_t WS_Z = WS_XN + 32 * MiB;
constexpr size_t WS_OB = WS_Z + 224 * MiB, WS_SG = WS_OB + 32 * MiB, WS_MRG = WS_SG + 32 * MiB;
constexpr size_t WS_Y = WS_MRG + 32 * MiB;
constexpr size_t WS_H2 = WS_Y + 64 * MiB;
constexpr size_t WS_XG = WS_H2 + 32 * MiB;
constexpr size_t WS_HID = WS_XG + 64 * MiB;
constexpr size_t WS_YC = WS_HID + 128 * MiB;
constexpr size_t WS_O1 = WS_YC + 64 * MiB;
constexpr size_t WS_END = WS_O1 + 64 * MiB;
constexpr int CW_BAR = 4096, CW_QUEUE = 8192;
constexpr int RING_BYTES = 131072, LDSCTL_OFF = RING_BYTES, MISC_OFF = LDSCTL_OFF + 320, LDS_BYTES = 147456;
constexpr int NWAVES = 8;
constexpr int NPHASE = 2 + 10 * DEPTH;

typedef float f32x4g __attribute__((ext_vector_type(4)));
typedef unsigned u32x2 __attribute__((ext_vector_type(2)));

__device__ __forceinline__ float wave_sum(float v) {
    v = att::row16_sum(v); v += att::swz_xor<16>(v);
    auto rr = __builtin_amdgcn_permlane32_swap(__float_as_uint(v), __float_as_uint(v), false, false);
    return __uint_as_float(rr[0]) + __uint_as_float(rr[1]);
}
__device__ __forceinline__ float bflo(unsigned w) { return __builtin_bit_cast(float, w << 16); }
__device__ __forceinline__ float bfhi(unsigned w) { return __builtin_bit_cast(float, w & 0xffff0000u); }

__device__ __forceinline__ void tr_item(const float* W, int K, int N, bf16* WT, int k0, int n0, int drow0, LAS float* scr, int lane) {
#pragma unroll 8
    for (int i = 0; i < 32; ++i) { const int kk = 2 * i + (lane >> 5); scr[kk * 33 + (lane & 31)] = __builtin_nontemporal_load(W + (size_t)(k0 + kk) * N + n0 + (lane & 31)); }
    LDS_WAIT(); asm volatile("" ::: "memory");
    const int c = lane & 7;
#pragma unroll
    for (int j = 0; j < 4; ++j) { const int n = (lane >> 3) + 8 * j; const LAS float* s = scr + (8 * c) * 33 + n;
        v4u o; o.x = pk2(s[0 * 33], s[1 * 33]); o.y = pk2(s[2 * 33], s[3 * 33]); o.z = pk2(s[4 * 33], s[5 * 33]); o.w = pk2(s[6 * 33], s[7 * 33]);
        __builtin_nontemporal_store(o, (GAS v4u*)(WT + (size_t)(drow0 + n) * K + k0 + 8 * c)); }
    LDS_WAIT(); asm volatile("" ::: "memory");
}

constexpr float W8_SCALE = 128.0f; constexpr int W8_E8M0 = 2;
__device__ __forceinline__ void tr_item8(const float* W, int K, int N, unsigned char* WT, int k0, int n0, int drow0, LAS float* scr, int lane) {
#pragma unroll 8
    for (int i = 0; i < 32; ++i) { const int kk = 2 * i + (lane >> 5); scr[kk * 33 + (lane & 31)] = __builtin_nontemporal_load(W + (size_t)(k0 + kk) * N + n0 + (lane & 31)); }
    LDS_WAIT(); asm volatile("" ::: "memory");
    const int c = lane & 7;
#pragma unroll
    for (int j = 0; j < 4; ++j) { const int n = (lane >> 3) + 8 * j; const LAS float* s = scr + (8 * c) * 33 + n;
        u32x2 o; o.x = pg8::pk4_fp8(s[0 * 33] * W8_SCALE, s[1 * 33] * W8_SCALE, s[2 * 33] * W8_SCALE, s[3 * 33] * W8_SCALE); o.y = pg8::pk4_fp8(s[4 * 33] * W8_SCALE, s[5 * 33] * W8_SCALE, s[6 * 33] * W8_SCALE, s[7 * 33] * W8_SCALE);
        __builtin_nontemporal_store(o, (GAS u32x2*)(WT + (size_t)(drow0 + n) * K + k0 + 8 * c)); }
    LDS_WAIT(); asm volatile("" ::: "memory");
}

__device__ __forceinline__ void modulate_store(const f32x4g (&v)[4], float rstd, const float* g, const float* sh, const float* sc, bf16* orow, unsigned char* orow8, int lane) {
#pragma unroll
    for (int j = 0; j < 4; ++j) { const int col = 4 * lane + 256 * j;
        const f32x4g gv = *(const f32x4g*)(g + col), sv = *(const f32x4g*)(sh + col), cv = *(const f32x4g*)(sc + col);
        const f32x4g h = v[j] * rstd * gv * (cv + 1.0f) + sv;
        u32x2 w; w.x = pk2(h.x, h.y); w.y = pk2(h.z, h.w); *(u32x2*)(orow + col) = w;
        *(unsigned*)(orow8 + col) = pg8::pk4_fp8(h.x, h.y, h.z, h.w); }
}

#ifndef PH_EN
#define PH_EN(k) 1
#endif
#ifndef MK_DUP_KIND
#define MK_DUP_KIND (-1)
#endif
#define DUPN(k) (((k) == MK_DUP_KIND || ((k) == 3 && (MK_DUP_KIND >= 12 && MK_DUP_KIND <= 17))) ? 2 : 1)
#ifndef MK_SINGLE
#define MK_SINGLE 1
#endif
struct Args { const float* in[26]; float* out; unsigned char* ws; int ph_lo, ph_hi, single, pad; };

__global__ void __launch_bounds__(NWAVES * 64, 2) mk_fwd(Args args) {
    extern __shared__ __attribute__((aligned(16))) unsigned char lds[];
    LAS unsigned char* const ldsl = (LAS unsigned char*)lds;
    volatile LAS unsigned* const MISC = (volatile LAS unsigned*)(ldsl + MISC_OFF);
    constexpr int G = 256; const int bx = blockIdx.x; const int vcu = (bx & 7) * (G / 8) + (bx >> 3);
    const int NGW = G * NWAVES;
    const int wave = __builtin_amdgcn_readfirstlane((int)threadIdx.x >> 6);
    unsigned char* ws_raw = args.ws;
    GAS unsigned char* ws = (GAS unsigned char*)ws_raw;
    gu32* const ctl = (gu32*)(ws + WS_CTL);
    for (int u = threadIdx.x; u < (LDS_BYTES - LDSCTL_OFF) / 4; u += NWAVES * 64) ((LAS unsigned*)(ldsl + LDSCTL_OFF))[u] = 0u;
    __syncthreads();
    XcdBarrier bar; bar.bar = (unsigned*)(ctl + CW_BAR); bar.x = 0; bar.st = nullptr; bar.w = wave;
#if MK_SINGLE
    bar = xcd_barrier_post((unsigned*)(ctl + CW_BAR), MISC + 8);
#else
    const int lo = args.ph_lo, hi = args.ph_hi;
#endif
#if MK_SINGLE
#define IN(k) true
#else
#define IN(k) (lo <= (k) && (k) < hi)
#endif
#define PHASE_ENV() int l_op_ = l; unsigned char* ws_op_ = args.ws; asm volatile("" : "+s"(l_op_), "+s"(ws_op_)); const int l = l_op_; GAS unsigned char* const ws = (GAS unsigned char*)ws_op_; \
    GAS unsigned char* const wl = ws + WS_W + (size_t)l * W_LAYER; const float* const md0 = MOD + (size_t)l * BATCH * 6144; (void)wl; (void)md0
#define PHASE_IDS() int lane_p; asm volatile("v_mbcnt_lo_u32_b32 %0, -1, 0\n\tv_mbcnt_hi_u32_b32 %0, -1, %0" : "=v"(lane_p)); const int lane = lane_p, tid = wave * 64 + lane, gw = vcu * NWAVES + wave; (void)tid; (void)gw
#if MK_SINGLE
#define SEAM(k) do { if ((k) + 1 < NPHASE) { XcdBarrier b_ = bar; unsigned z_ = 0u; asm volatile("" : "+s"(z_), "+s"(b_.x)); b_.bar = bar.bar + z_; xcd_barrier(b_); } } while (0)
#else
#define SEAM(k) do { } while (0)
#endif

#define MOD ((float*)(GAS float*)(ws + WS_MOD))
#define LAMV ((float*)(GAS float*)(ws + WS_MOD + 256 * 1024))
#define WSPB ((bf16*)(GAS bf16*)(ws + WS_WSP))
#define AFF ((float*)(GAS float*)(ws + WS_AFF))
#define SLOTMAP ((int*)(GAS int*)(ws + WS_SLOT))
#define IDX ((int*)(GAS int*)(ws + WS_IDX))
#define GATEV ((float*)(GAS float*)(ws + WS_IDX + 512 * 1024))
#define KN2 ((float*)(GAS float*)(ws + WS_KN2))
#define XN ((bf16*)(GAS bf16*)(ws + WS_XN))
#define ZB ((bf16*)(GAS bf16*)(ws + WS_Z))
#define QB ZB
#define KB (ZB + (size_t)M * 1024)
#define VB (ZB + 2 * (size_t)M * 1024)
#define UB (ZB + 3 * (size_t)M * 1024)
#define VGB (ZB + 4 * (size_t)M * 1024)
#define GAB (ZB + 5 * (size_t)M * 1024)
#define GBB (ZB + 6 * (size_t)M * 1024)
#define OB ((bf16*)(GAS bf16*)(ws + WS_OB))
#define SGB ((bf16*)(GAS bf16*)(ws + WS_SG))
#define MRG ((bf16*)(GAS bf16*)(ws + WS_MRG))
#define Y ((bf16*)(GAS bf16*)(ws + WS_Y))
#define H2 ((bf16*)(GAS bf16*)(ws + WS_H2))
#define XG ((bf16*)(GAS bf16*)(ws + WS_XG))
#define XN8 ((unsigned char*)(GAS unsigned char*)(ws + WS_XG + 32 * MiB))
#define HID ((bf16*)(GAS bf16*)(ws + WS_HID))
#define YC ((bf16*)(GAS bf16*)(ws + WS_YC))
#define O1S ((float*)(GAS float*)(ws + WS_O1))
#define XOUT (args.out)
#define XR ((bf16*)(GAS bf16*)(ws + WS_XG))

    if (PH_EN(0) && IN(0)) for (int rep_ = 0; rep_ < DUPN(0); ++rep_) { PHASE_IDS();
        { LAS float* cact = (LAS float*)ldsl; LAS float* part = cact + 2048;
          const float* c = args.in[1];
          for (int i = tid; i < 2048; i += 512) { const float x = c[i]; cact[i] = x / (1.0f + __expf(-x)); }
          __syncthreads();
          for (int it = vcu; it < DEPTH * 96; it += G) {
              const int l = it / 96, cb = it % 96, col = cb * 64 + lane;
              const float* wp = args.in[2] + (size_t)l * 1024 * 6144 + (size_t)(wave * 128) * 6144 + col;
              float a0 = 0.f, a1 = 0.f;
#pragma unroll 8
              for (int k = 0; k < 128; ++k) { const float w = wp[(size_t)k * 6144]; a0 += cact[wave * 128 + k] * w; a1 += cact[1024 + wave * 128 + k] * w; }
              part[(wave * 2 + 0) * 64 + lane] = a0; part[(wave * 2 + 1) * 64 + lane] = a1;
              __syncthreads();
              if (wave < 2) { float s = 0.f;
#pragma unroll
                  for (int w8 = 0; w8 < 8; ++w8) s += part[(w8 * 2 + wave) * 64 + lane];
                  MOD[((size_t)l * BATCH + wave) * 6144 + col] = s + args.in[3][(size_t)l * 6144 + col]; }
              __syncthreads();
          }
          if (bx == 0 && tid < DEPTH) { const int l = tid; float d1 = 0.f, d2 = 0.f;
              for (int i = 0; i < 64; ++i) { d1 += args.in[7][l * 64 + i] * args.in[8][l * 64 + i]; d2 += args.in[9][l * 64 + i] * args.in[10][l * 64 + i]; }
              const float li = 0.8f - 0.6f * __expf(-0.3f * (float)l);
              LAMV[2 * l] = __expf(d1) - __expf(d2) + li; LAMV[2 * l + 1] = 1.0f - li; }
          __syncthreads();
        }
        { const float* wsp = args.in[14]; const int n8 = DEPTH * 8 * 128 * 128 / 8;
          for (int i = gw * 64 + lane; i < n8; i += NGW * 64) { const f32x4g a = *(const f32x4g*)(wsp + (size_t)i * 8), b = *(const f32x4g*)(wsp + (size_t)i * 8 + 4);
              v4u o; o.x = pk2(a.x, a.y); o.y = pk2(a.z, a.w); o.z = pk2(b.x, b.y); o.w = pk2(b.z, b.w); *(v4u*)(WSPB + (size_t)i * 8) = o; } }
        { LAS float* scr = (LAS float*)(ldsl + wave * 16384);
          constexpr int I_IN = 16 * 224, I_SQ = 16 * 32, I_GU = 16 * 64, I_DN = 32 * 32;
          constexpr int PER_LAYER = I_IN + 3 * I_SQ + 2 * NE * I_GU + NE * I_DN;
          for (int it = gw; it < DEPTH * PER_LAYER; it += NGW) {
              const int l = it / PER_LAYER; int r = it % PER_LAYER;
              GAS unsigned char* wl = ws + WS_W + (size_t)l * W_LAYER;
              if (r < I_IN) { const int kb = r / 224, nb = r % 224;
                  if (nb < 64) tr_item(args.in[6] + (size_t)l * 1024 * NIN, 1024, NIN, (bf16*)(GAS bf16*)(wl + W_IN), kb * 64, nb * 32, nb * 32, scr, lane);
                  else tr_item8(args.in[6] + (size_t)l * 1024 * NIN, 1024, NIN, (unsigned char*)(GAS unsigned char*)(wl + W_IN + 4 * MiB), kb * 64, nb * 32, nb * 32 - 2048, scr, lane);
                  continue; } r -= I_IN;
              if (r < 3 * I_SQ) { const int w = r / I_SQ, q = r % I_SQ, kb = q / 32, nb = q % 32;
                  tr_item(args.in[16 + w] + (size_t)l * 1024 * 1024, 1024, 1024, (bf16*)(GAS bf16*)(wl + (w == 0 ? W_A : w == 1 ? W_B : W_O)), kb * 64, nb * 32, nb * 32, scr, lane); continue; } r -= 3 * I_SQ;
              if (r < 2 * NE * I_GU) { const int up = r / (NE * I_GU), q = r % (NE * I_GU), e = q / I_GU, q2 = q % I_GU, kb = q2 / 64, nb = q2 % 64, n0 = nb * 32;
                  tr_item8(args.in[23 + up] + ((size_t)l * NE + e) * 1024 * FF, 1024, FF, (unsigned char*)(GAS unsigned char*)(wl + W_GU), kb * 64, n0, e * 4096 + 256 * (n0 >> 7) + (n0 & 127) + up * 128, scr, lane); continue; } r -= 2 * NE * I_GU;
              { const int e = r / I_DN, q = r % I_DN, kb = q / 32, nb = q % 32;
                  tr_item8(args.in[25] + ((size_t)l * NE + e) * FF * 1024, FF, 1024, (unsigned char*)(GAS unsigned char*)(wl + W_D), kb * 64, nb * 32, e * 1024 + nb * 32, scr, lane); }
          } }
        SEAM(0);
    }
    if (PH_EN(1) && IN(1)) { PHASE_IDS();
        f32x4g nx0[4];
#pragma unroll
        for (int j = 0; j < 4; ++j) nx0[j] = ((const f32x4g*)(args.in[0] + (size_t)gw * D) + lane)[64 * j];
#pragma nounroll
        for (int bb = 0; bb < BATCH; ++bb) { const float* md = MOD + (size_t)bb * 6144;
          f32x4g RB0[4], RS0[4];
#pragma unroll
          for (int j = 0; j < 4; ++j) { const int col = 4 * lane + 256 * j; RB0[j] = *(const f32x4g*)(args.in[4] + col) * (*(const f32x4g*)(md + 1024 + col) + 1.0f); RS0[j] = *(const f32x4g*)(md + col); }
#pragma nounroll
          for (int k4 = 0; k4 < 4; ++k4) { const int m = gw + (bb * 4 + k4) * NGW; f32x4g v[4]; float s = 0.f;
#pragma unroll
            for (int j = 0; j < 4; ++j) { v[j] = nx0[j]; s += (v[j].x * v[j].x + v[j].y * v[j].y) + (v[j].z * v[j].z + v[j].w * v[j].w); }
            { const int mn = (m + NGW < M) ? m + NGW : m;
#pragma unroll
              for (int j = 0; j < 4; ++j) nx0[j] = ((const f32x4g*)(args.in[0] + (size_t)mn * D) + lane)[64 * j];
              __builtin_amdgcn_sched_barrier(0); }
            const float rstd = __builtin_amdgcn_rsqf(wave_sum(s) * (1.f / D) + NORM_EPS);
#pragma unroll
            for (int j = 0; j < 4; ++j) { const int col = 4 * lane + 256 * j; const f32x4g h = (v[j] * rstd) * RB0[j] + RS0[j];
                u32x2 w; w.x = pk2(h.x, h.y); w.y = pk2(h.z, h.w); *(u32x2*)(XN + (size_t)m * D + col) = w;
                *(unsigned*)(XN8 + (size_t)m * D + col) = pg8::pk4_fp8(h.x, h.y, h.z, h.w);
                u32x2 wx; wx.x = pk2(v[j].x, v[j].y); wx.y = pk2(v[j].z, v[j].w); *(u32x2*)(XR + (size_t)m * D + col) = wx; }
          } }
        if (gw * 128 < M * 16) { unsigned z_ = 0u; asm volatile("" : "+v"(z_)); *(u32x2*)(KN2 + gw * 128 + 2 * lane) = (u32x2){z_, z_}; }
        SEAM(1);
    }

#pragma nounroll
    for (int l = 0; l < DEPTH; ++l) {
        const int pb = 2 + 10 * l;
#if !MK_SINGLE
        if (pb >= hi) break;
#endif
        if (PH_EN(2) && IN(pb + 0)) for (int rep_ = 0; rep_ < DUPN(2); ++rep_) { PHASE_ENV();
            { pg8::Gemm g{XN, (const bf16*)(GAS bf16*)(wl + W_IN), M, 2048, D}; pg8::StaticOrder S; S.init(M, 2048, G, bx);
              pg8::EpiIn E{ZB, (DUPN(2) == 2 && rep_ == 0) ? (float*)nullptr : KN2, 0, 1.0f};
              pg8::gemm_phase<pg8::EpiIn, pg8::StaticOrder, true, true>(ldsl, g, S, E, wave); }
            { pg8::Gemm g{(const bf16*)XN8, (const bf16*)(GAS bf16*)(wl + W_IN + 4 * MiB), M, NIN - 2048, D / 2}; pg8::StaticOrder S; S.init(M, NIN - 2048, G, bx);
              pg8::EpiIn E{ZB, (float*)nullptr, 2, 1.0f / W8_SCALE};
              pg8::gemm_phase<pg8::EpiIn, pg8::StaticOrder, true, true, false, 0, W8_E8M0>(ldsl, g, S, E, wave); }
            SEAM(pb + 0);
        }
        if (PH_EN(3) && IN(pb + 1)) for (int rep_ = 0; rep_ < DUPN(3); ++rep_) { PHASE_ENV(); PHASE_IDS();
            const float lam = LAMV[2 * l], onemli = LAMV[2 * l + 1];
            const int xme = (int)(xb_xcc_id() & 7u);
            for (int kq = 0; kq < 8; ++kq) { const int xq = (xme + kq) & 7;
            for (;;) {
                if (tid == 0) MISC[16] = __hip_atomic_fetch_add((unsigned*)(ctl + CW_QUEUE + 64 * (l * 8 + xq + 32 * rep_)), 1u, __ATOMIC_RELAXED, __HIP_MEMORY_SCOPE_AGENT);
                __syncthreads(); const int uq = (int)MISC[16]; __syncthreads();
                if (uq >= 160) break;
                if (uq < 128) { if (PH_EN(12) && !(MK_DUP_KIND == 13 && rep_ == 1) && !(MK_DUP_KIND >= 14 && rep_ == 1 && (uq >> 5) != MK_DUP_KIND - 14)) {        const int c_ = xq & 3, k_ = uq >> 5, b = c_ >> 1, qb = (c_ & 1) * 32 + (uq & 31), h = (xq >> 2) ? (k_ == 0 ? 6 : k_ == 1 ? 5 : k_ == 2 ? 2 : 0) : (k_ == 0 ? 7 : k_ == 1 ? 4 : k_ == 2 ? 3 : 1);
                    att::attn_unit(b, h, qb, QB, KB, VB, OB, KN2, lam, onemli, args.in[11] + l * 128, (char*)lds, wave); }
                    continue; }
            if (PH_EN(13) && !((MK_DUP_KIND == 12 || MK_DUP_KIND >= 14) && rep_ == 1)) { const int uid = xq * 32 + (uq - 128); const int lane = att::lane_id_asm(), tid = wave * 64 + lane;
                const int ch = uid >> 1, gh = uid & 1; const size_t tok0 = (size_t)ch * 128;
                LAS float* st = (LAS float*)(ldsl + LDSCTL_OFF + 2048);
                v4u xa[2][8], xb[2][8];
#pragma unroll
                for (int rb = 0; rb < 2; ++rb)
#pragma unroll
                    for (int rr = 0; rr < 8; ++rr) { const bf16* vp = VGB + (tok0 + wave * 16 + rb * 8 + rr) * 1024 + lane * 8; xa[rb][rr] = *(const v4u*)vp; xb[rb][rr] = *(const v4u*)(vp + 512); }
                __builtin_amdgcn_sched_barrier(0);
#pragma unroll
                for (int rb = 0; rb < 2; ++rb) {
#pragma unroll
                    for (int rr = 0; rr < 8; ++rr) { const v4u a = xa[rb][rr], b2 = xb[rb][rr]; const int row = wave * 16 + rb * 8 + rr;
                        float x[16] = {bflo(a.x), bfhi(a.x), bflo(a.y), bfhi(a.y), bflo(a.z), bfhi(a.z), bflo(a.w), bfhi(a.w), bflo(b2.x), bfhi(b2.x), bflo(b2.y), bfhi(b2.y), bflo(b2.z), bfhi(b2.z), bflo(b2.w), bfhi(b2.w)};
                        float s = 0.f;
#pragma unroll
                        for (int q = 0; q < 16; ++q) s += x[q];
                        const float mean = wave_sum(s) * (1.f / 1024.f); float s2 = 0.f;
#pragma unroll
                        for (int q = 0; q < 16; ++q) { const float d = x[q] - mean; s2 += d * d; }
                        const float rstd = __builtin_amdgcn_rsqf(wave_sum(s2) * (1.f / 1024.f) + NORM_EPS);
                        if (lane == 0) { st[row * 2] = mean; st[row * 2 + 1] = rstd; } } }
                __syncthreads();
#pragma nounroll
                for (int gp = 0; gp < 2; ++gp) {
                    att::bf16x8 pa[8];
                    { const int gs = wave >> 2, tb = wave & 3, g = gh * 4 + gp * 2 + gs, r32 = lane & 31, hi2 = lane >> 5;
                      const bf16* wp = WSPB + (((size_t)l * 8 + g) * 128 + tb * 32 + r32) * 128 + hi2 * 8;
#pragma unroll
                      for (int ks = 0; ks < 8; ++ks) pa[ks] = *(const att::bf16x8*)(wp + ks * 16);
                      __builtin_amdgcn_sched_barrier(0); }
                    { const int sr = tid >> 4, sc = (tid & 15) * 8;
#pragma unroll
                    for (int gs = 0; gs < 2; ++gs) { const int g = gh * 4 + gp * 2 + gs; const int colg = g * 128 + sc;
                        const f32x4g lg0 = *(const f32x4g*)(args.in[12] + l * 1024 + colg), lg1 = *(const f32x4g*)(args.in[12] + l * 1024 + colg + 4);
                        const f32x4g lb0 = *(const f32x4g*)(args.in[13] + l * 1024 + colg), lb1 = *(const f32x4g*)(args.in[13] + l * 1024 + colg + 4);
                        v4u av[4];
#pragma unroll
                        for (int q = 0; q < 4; ++q) av[q] = *(const v4u*)(VGB + (tok0 + sr + 32 * q) * 1024 + colg);
#pragma unroll
                        for (int q = 0; q < 4; ++q) { const int row = sr + 32 * q; const v4u a = av[q];
                            const float mean = st[row * 2], rstd = st[row * 2 + 1];
                            v4u o; o.x = pk2((bflo(a.x) - mean) * rstd * lg0.x + lb0.x, (bfhi(a.x) - mean) * rstd * lg0.y + lb0.y);
                            o.y = pk2((bflo(a.y) - mean) * rstd * lg0.z + lb0.z, (bfhi(a.y) - mean) * rstd * lg0.w + lb0.w);
                            o.z = pk2((bflo(a.z) - mean) * rstd * lg1.x + lb1.x, (bfhi(a.z) - mean) * rstd * lg1.y + lb1.y);
                            o.w = pk2((bflo(a.w) - mean) * rstd * lg1.z + lb1.z, (bfhi(a.w) - mean) * rstd * lg1.w + lb1.w);
                            *(LAS v4u*)(ldsl + gs * 32768 + (row >> 6) * 16384 + att::v_st(row & 63, sc)) = o; } } }
                    __syncthreads();
                    v4u uu8[8]; float bsv8[8];
#pragma unroll
                    for (int i = 0; i < 8; ++i) { const int c = tid + 512 * i, gs = c >> 11, t = (c >> 4) & 127, k0 = (c & 15) * 8, g = gh * 4 + gp * 2 + gs;
                        bsv8[i] = args.in[15][((size_t)l * 8 + g) * 128 + t]; uu8[i] = *(const v4u*)(UB + (tok0 + t) * 1024 + g * 128 + k0); }
                    __builtin_amdgcn_sched_barrier(0);
                    { const int gs = wave >> 2, tb = wave & 3, g = gh * 4 + gp * 2 + gs, r32 = lane & 31, hi2 = lane >> 5;
                      att::f32x16 o[4] = {};
                      const int vb = (int)(uintptr_t)(lds + gs * 32768) + att::v_rd_base(lane);
                      att::pv_d0(o, vb, pa[0], pa[1], pa[2], pa[3]);
                      att::pv_d0(o, vb + 16384, pa[4], pa[5], pa[6], pa[7]);
                      __syncthreads();
                      LAS float* ot = (LAS float*)(ldsl + gs * 65536) + (tb * 32 + 4 * hi2) * 128 + r32;
#pragma unroll
                      for (int r = 0; r < 16; ++r)
#pragma unroll
                          for (int d0 = 0; d0 < 4; ++d0) ot[((r & 3) + 8 * (r >> 2)) * 128 + d0 * 32] = o[d0][r]; }
                    __syncthreads();
#pragma unroll
                    for (int i = 0; i < 8; ++i) { const int c = tid + 512 * i, gs = c >> 11, t = (c >> 4) & 127, k0 = (c & 15) * 8, g = gh * 4 + gp * 2 + gs;
                        const LAS float* op = (const LAS float*)(ldsl + gs * 65536) + t * 128 + k0;
                        const f32x4g m0 = *(const LAS f32x4g*)op, m1 = *(const LAS f32x4g*)(op + 4);
                        const float bsv = bsv8[i];
                        const size_t off = (tok0 + t) * 1024 + g * 128 + k0;
                        const v4u uu = uu8[i];
                        v4u w; w.x = pk2(bflo(uu.x) * (m0.x + bsv), bfhi(uu.x) * (m0.y + bsv)); w.y = pk2(bflo(uu.y) * (m0.z + bsv), bfhi(uu.y) * (m0.w + bsv));
                        w.z = pk2(bflo(uu.z) * (m1.x + bsv), bfhi(uu.z) * (m1.y + bsv)); w.w = pk2(bflo(uu.w) * (m1.z + bsv), bfhi(uu.w) * (m1.w + bsv));
                        *(v4u*)(SGB + off) = w; }
                    __syncthreads();
                }
            } } }
            SEAM(pb + 1);
        }
        if (PH_EN(4) && IN(pb + 2)) for (int rep_ = 0; rep_ < DUPN(4); ++rep_) { PHASE_ENV();
            { pg8::Gemm g{OB, (const bf16*)(GAS bf16*)(wl + W_A), 2 * M, 2 * D, D}; pg8::AbOrder S; S.S.init(M, D, G, bx); pg8::EpiGate2 E{GAB, MRG};
              pg8::gemm_phase<pg8::EpiGate2, pg8::AbOrder, true, true>(ldsl, g, S, E, wave); }
            SEAM(pb + 2);
        }
        if (PH_EN(5) && IN(pb + 3)) for (int rep_ = 0; rep_ < DUPN(5); ++rep_) { PHASE_ENV();
            pg8::Gemm g{MRG, (const bf16*)(GAS bf16*)(wl + W_O), M, D, D}; pg8::StaticOrder S; S.init(M, D, G, bx); pg8::EpiYb E{Y};
            pg8::gemm_phase<pg8::EpiYb, pg8::StaticOrder, true, true>(ldsl, g, S, E, wave);
            SEAM(pb + 3);
        }
        if (PH_EN(6) && IN(pb + 4)) for (int rep_ = 0; rep_ < DUPN(6); ++rep_) { PHASE_ENV(); PHASE_IDS();
            bf16* const xo_ = (DUPN(6) == 2 && rep_ == 0) ? (bf16*)O1S : XR; bf16* const h2o_ = (DUPN(6) == 2 && rep_ == 0) ? (bf16*)O1S + (size_t)M * D : H2;
            LAS float* wr = (LAS float*)ldsl;
            { const float* wrg = args.in[21] + (size_t)l * 1024 * NE;
              for (int i = tid; i < 1024 * NE; i += 512) wr[(i & 15) * 1028 + (i >> 4)] = wrg[i]; }
            __syncthreads();
            const bf16* xin = XR;
            const int e_l = ((lane >> 5) & 1) * 8 + ((lane >> 4) & 1) * 4 + ((lane >> 3) & 1) * 2 + ((lane >> 2) & 1);
            const float br = args.in[22][l * NE + e_l];
            u32x2 ny[4]; u32x2 nx[4];
#pragma unroll
            for (int j = 0; j < 4; ++j) { ny[j] = __builtin_nontemporal_load((const u32x2*)(Y + (size_t)gw * D + 4 * lane + 256 * j)); nx[j] = *(const u32x2*)(xin + (size_t)gw * D + 4 * lane + 256 * j); }
#pragma nounroll
            for (int bb = 0; bb < BATCH; ++bb) { const float* md = md0 + (size_t)bb * 6144;
              f32x4g PA[4], PB[4], PS[4];
              { const float* gpo = args.in[5] + l * 1024; const float* gpr = args.in[19] + l * 1024;
#pragma unroll
                for (int j = 0; j < 4; ++j) { const int col = 4 * lane + 256 * j;
                    const f32x4g gp = *(const GAS f32x4g*)(gpo + col), gt = *(const GAS f32x4g*)(md + 2048 + col);
                    const f32x4g gv = *(const GAS f32x4g*)(gpr + col), sv = *(const GAS f32x4g*)(md + 3072 + col), cv = *(const GAS f32x4g*)(md + 4096 + col);
                    PA[j] = gt * gp; PB[j] = gv * (cv + 1.0f); PS[j] = sv; } }
#pragma nounroll
              for (int k4 = 0; k4 < 4; ++k4) { const int m = gw + (bb * 4 + k4) * NGW;
                f32x4g v[4], xv[4]; float s = 0.f;
#pragma unroll
                for (int j = 0; j < 4; ++j) { const u32x2 yb_ = ny[j]; v[j] = (f32x4g){bflo(yb_.x), bfhi(yb_.x), bflo(yb_.y), bfhi(yb_.y)}; xv[j] = (f32x4g){bflo(nx[j].x), bfhi(nx[j].x), bflo(nx[j].y), bfhi(nx[j].y)}; }
                { const int mn = (m + NGW < M) ? m + NGW : m;
#pragma unroll
                  for (int j = 0; j < 4; ++j) { ny[j] = __builtin_nontemporal_load((const u32x2*)(Y + (size_t)mn * D + 4 * lane + 256 * j)); nx[j] = *(const u32x2*)(xin + (size_t)mn * D + 4 * lane + 256 * j); }
                  __builtin_amdgcn_sched_barrier(0); }
#pragma unroll
                for (int j = 0; j < 4; ++j) s += (v[j].x * v[j].x + v[j].y * v[j].y) + (v[j].z * v[j].z + v[j].w * v[j].w);
                const float rstd = __builtin_amdgcn_rsqf(wave_sum(s) * (1.f / D) + NORM_EPS); float s2 = 0.f;
#pragma unroll
                for (int j = 0; j < 4; ++j) { const int col = 4 * lane + 256 * j;
                    v[j] = xv[j] + (v[j] * rstd) * PA[j];
                    { u32x2 w_; w_.x = pk2(v[j].x, v[j].y); w_.y = pk2(v[j].z, v[j].w); *(u32x2*)(xo_ + (size_t)m * D + col) = w_; }
                    s2 += (v[j].x * v[j].x + v[j].y * v[j].y) + (v[j].z * v[j].z + v[j].w * v[j].w); }
                const float rstd2 = __builtin_amdgcn_rsqf(wave_sum(s2) * (1.f / D) + NORM_EPS);
                float acc[16];
#pragma unroll
                for (int e = 0; e < 16; ++e) acc[e] = 0.f;
                f32x4g hq[4];
#pragma unroll
                for (int j = 0; j < 4; ++j) { const int col = 4 * lane + 256 * j;
                    hq[j] = (v[j] * rstd2) * PB[j] + PS[j];
                    *(unsigned*)((unsigned char*)h2o_ + (size_t)m * D + col) = pg8::pk4_fp8(hq[j].x, hq[j].y, hq[j].z, hq[j].w); }
                f32x4g wq[2][4];
#define ROW1_LDG(buf_, g_) do { _Pragma("unroll") for (int q = 0; q < 4; ++q) wq[buf_][q] = *(const LAS f32x4g*)(wr + (4 * ((g_) & 3) + q) * 1028 + 4 * lane + 256 * ((g_) >> 2)); } while (0)
                ROW1_LDG(0, 0);
#pragma unroll
                for (int g = 0; g < 16; ++g) {
                    if (g + 1 < 16) ROW1_LDG((g + 1) & 1, g + 1);
                    asm volatile("" ::: "memory");
                    const f32x4g h = hq[g >> 2];
#pragma unroll
                    for (int q = 0; q < 4; ++q) { const f32x4g wv = wq[g & 1][q]; acc[4 * (g & 3) + q] += (h.x * wv.x + h.y * wv.y) + (h.z * wv.z + h.w * wv.w); }
                    asm volatile("" ::: "memory"); }
#undef ROW1_LDG
#pragma unroll
                for (int st = 0; st < 4; ++st) { const int sh = 32 >> st, half = 8 >> st; const bool up = (lane & sh) != 0;
#pragma unroll
                    for (int i = 0; i < half; ++i) { const float keep = up ? acc[i + half] : acc[i], send = up ? acc[i] : acc[i + half]; acc[i] = keep + __uint_as_float(xl_idx(__float_as_uint(send), lane ^ sh)); } }
                float lg = acc[0]; lg += xl_xor<2>(lg); lg += xl_xor<1>(lg); lg += br;
                float mx = xl_max32(lg); mx = fmaxf(mx, xl_xor<16>(mx)); mx = fmaxf(mx, xl_xor<8>(mx)); mx = fmaxf(mx, xl_xor<4>(mx));
                const float ex = __expf(lg - mx); float sm = xl_add32(ex); sm += xl_xor<16>(sm); sm += xl_xor<8>(sm); sm += xl_xor<4>(sm);
                if ((lane & 3) == 0) AFF[(size_t)m * NE + e_l] = ex / sm;
                if (lane < 16) SLOTMAP[(size_t)m * NE + lane] = 0;
              } }
            SEAM(pb + 4);
        }
        if (PH_EN(7) && IN(pb + 5)) for (int rep_ = 0; rep_ < DUPN(7); ++rep_) { PHASE_ENV(); PHASE_IDS();
            for (int uid = vcu; uid < BATCH * NE; uid += G) { const int b = uid / NE, e = uid % NE;
                LAS unsigned* hist = (LAS unsigned*)ldsl; LAS unsigned* sh = hist + 256;
                float v[16]; unsigned bits[16]; const int t0 = tid * 16;
#pragma unroll
                for (int i = 0; i < 16; ++i) { v[i] = AFF[((size_t)b * SEQ + t0 + i) * NE + e]; bits[i] = __float_as_uint(v[i]); }
                unsigned pref = 0, need = CAP;
#pragma nounroll
                for (int pass = 0; pass < 4; ++pass) { const int shift = 24 - 8 * pass;
                    if (tid < 256) hist[tid] = 0u; __syncthreads();
#pragma unroll
                    for (int i = 0; i < 16; ++i) { const bool in = (unsigned)((unsigned long long)bits[i] >> (shift + 8)) == pref; if (in) atomicAdd((unsigned*)&hist[(bits[i] >> shift) & 255u], 1u); }
                    __syncthreads();
                    if (wave == 0) { const unsigned h0 = hist[4 * lane], h1 = hist[4 * lane + 1], h2 = hist[4 * lane + 2], h3 = hist[4 * lane + 3]; const unsigned c = h0 + h1 + h2 + h3;
                        unsigned s = c;
#pragma unroll
                        for (int o = 1; o < 64; o <<= 1) { const unsigned t = xl_idx(s, (lane + o) & 63); if (lane + o < 64) s += t; }
                        const unsigned above = s - c;
                        if (above < need && need <= s) { unsigned a = above; unsigned dsel, nn;
                            if (a + h3 >= need) { dsel = 3; nn = need - a; } else { a += h3;
                            if (a + h2 >= need) { dsel = 2; nn = need - a; } else { a += h2;
                            if (a + h1 >= need) { dsel = 1; nn = need - a; } else { a += h1; dsel = 0; nn = need - a; } } }
                            sh[0] = 4 * lane + dsel; sh[1] = nn; } }
                    __syncthreads();
                    pref = (pref << 8) | sh[0]; need = sh[1];
                    __syncthreads();
                }
                const unsigned thr = pref; unsigned ngt = 0, neq = 0;
#pragma unroll
                for (int i = 0; i < 16; ++i) { ngt += bits[i] > thr ? 1u : 0u; neq += bits[i] == thr ? 1u : 0u; }
                const unsigned packed = ngt | (neq << 16); unsigned inc = packed;
#pragma unroll
                for (int o = 1; o < 64; o <<= 1) { const unsigned t = xl_idx(inc, (lane - o) & 63); if (lane >= o) inc += t; }
                if (lane == 63) sh[8 + wave] = inc; __syncthreads();
                unsigned wbase = 0;
                for (int w = 0; w < wave; ++w) wbase += sh[8 + w];
                const unsigned exc = wbase + inc - packed; unsigned gtb = exc & 0xffffu, eqb = exc >> 16;
#pragma unroll
                for (int i = 0; i < 16; ++i) { const bool gt = bits[i] > thr, eq = bits[i] == thr;
                    if (gt || (eq && eqb < need)) { const unsigned slot = gtb + (eqb < need ? eqb : need); const int row = e * 2048 + b * 1024 + (int)slot; const int tok = b * SEQ + t0 + i;
                        IDX[row] = tok; GATEV[row] = v[i]; SLOTMAP[(size_t)tok * NE + e] = row + 1; }
                    gtb += gt ? 1u : 0u; eqb += eq ? 1u : 0u; }
                __syncthreads();
            }
            SEAM(pb + 5);
        }
        if (PH_EN(9) && IN(pb + 7)) for (int rep_ = 0; rep_ < DUPN(9); ++rep_) { PHASE_ENV(); PHASE_IDS();
            pg8::MoeOrder1 S{vcu, G};
            LAS int* tokl = (LAS int*)(ldsl + LDSCTL_OFF + 4096);
            for (int q = tid; q < 8 * 256; q += 512) { pg8::Unit u; if (S.next(q >> 8, u)) tokl[q] = IDX[u.pm * 256 + (q & 255)]; }
            __syncthreads();
            pg8::Gemm g{H2, (const bf16*)(GAS bf16*)(wl + W_GU), NSEL, NE * 4096, D / 2}; pg8::EpiMoe1 E{(unsigned char*)HID, 1.0f / W8_SCALE};
            pg8::gemm_phase<pg8::EpiMoe1, pg8::MoeOrder1, true, true, true, 0, W8_E8M0>(ldsl, g, S, E, wave, tokl);
            SEAM(pb + 7);
        }
        if (PH_EN(10) && IN(pb + 8)) for (int rep_ = 0; rep_ < DUPN(10); ++rep_) { PHASE_ENV();
            pg8::Gemm g{HID, (const bf16*)(GAS bf16*)(wl + W_D), NSEL, NE * 1024, FF / 2}; pg8::MoeOrder2 S{vcu, G}; pg8::EpiMoe2 E{YC, GATEV, 1.0f / W8_SCALE};
            pg8::gemm_phase<pg8::EpiMoe2, pg8::MoeOrder2, true, true, false, 0, W8_E8M0>(ldsl, g, S, E, wave);
            SEAM(pb + 8);
        }
        if (PH_EN(11) && IN(pb + 9)) for (int rep_ = 0; rep_ < DUPN(11); ++rep_) { PHASE_ENV(); PHASE_IDS();
            bf16* const xo_ = (DUPN(11) == 2 && rep_ == 0) ? (bf16*)O1S : XR; bf16* const xno_ = (DUPN(11) == 2 && rep_ == 0) ? (bf16*)O1S + (size_t)M * D : XN;
            int smn = 0;
            if (gw < M) smn = SLOTMAP[(size_t)gw * NE + (lane & 15)];
            u32x2 nxr[4];
#pragma unroll
            for (int j = 0; j < 4; ++j) nxr[j] = *(const u32x2*)(XR + (size_t)gw * D + 4 * lane + 256 * j);
#pragma nounroll
            for (int bb = 0; bb < BATCH; ++bb) { const float* md = md0 + (size_t)bb * 6144;
              f32x4g RPA[4], RPB[4], RPS[4];
#pragma unroll
              for (int j = 0; j < 4; ++j) { const int col = 4 * lane + 256 * j;
                  RPA[j] = *(const f32x4g*)(args.in[20] + l * 1024 + col) * *(const f32x4g*)(md + 5120 + col);
                  if (l + 1 < DEPTH) { const float* mdn = md + (size_t)BATCH * 6144;
                      RPB[j] = *(const f32x4g*)(args.in[4] + (l + 1) * 1024 + col) * (*(const f32x4g*)(mdn + 1024 + col) + 1.0f); RPS[j] = *(const f32x4g*)(mdn + col); }
                  else { RPB[j] = (f32x4g){0.f, 0.f, 0.f, 0.f}; RPS[j] = RPB[j]; } }
#pragma nounroll
              for (int k4 = 0; k4 < 4; ++k4) { const int m = gw + (bb * 4 + k4) * NGW;
                const int sm = smn; f32x4g xv[4];
#pragma unroll
                for (int j = 0; j < 4; ++j) xv[j] = (f32x4g){bflo(nxr[j].x), bfhi(nxr[j].x), bflo(nxr[j].y), bfhi(nxr[j].y)};
                { const int mn = (m + NGW < M) ? m + NGW : m;
                  if (m + NGW < M) smn = SLOTMAP[(size_t)mn * NE + (lane & 15)];
#pragma unroll
                  for (int j = 0; j < 4; ++j) nxr[j] = *(const u32x2*)(XR + (size_t)mn * D + 4 * lane + 256 * j);
                  __builtin_amdgcn_sched_barrier(0); }
                f32x4g y[4];
#pragma unroll
                for (int j = 0; j < 4; ++j) y[j] = (f32x4g){0.f, 0.f, 0.f, 0.f};
                unsigned mk = (unsigned)__ballot(sm != 0) & 0xffffu;
                while (mk != 0u) {
                    const int e0 = __builtin_ctz(mk); mk &= mk - 1u;
                    const int e1 = mk ? __builtin_ctz(mk) : -1; if (e1 >= 0) mk &= mk - 1u;
                    const int e2 = (e1 >= 0 && mk) ? __builtin_ctz(mk) : -1; if (e2 >= 0) mk &= mk - 1u;
                    const int e3 = (e2 >= 0 && mk) ? __builtin_ctz(mk) : -1; if (e3 >= 0) mk &= mk - 1u;
                    u32x2 w0[4], w1[4], w2[4], w3[4];
#pragma unroll
                    for (int j = 0; j < 4; ++j) { w1[j] = (u32x2){0u, 0u}; w2[j] = (u32x2){0u, 0u}; w3[j] = (u32x2){0u, 0u}; }
#define ROW2_LD(w_, e_) do { const u32x2* yp_ = (const u32x2*)(YC + (size_t)(__builtin_amdgcn_readlane(sm, e_) - 1) * D) + lane; _Pragma("unroll") for (int j = 0; j < 4; ++j) w_[j] = __builtin_nontemporal_load(yp_ + 64 * j); } while (0)
#define ROW2_AC(w_) do { _Pragma("unroll") for (int j = 0; j < 4; ++j) y[j] += (f32x4g){bflo(w_[j].x), bfhi(w_[j].x), bflo(w_[j].y), bfhi(w_[j].y)}; } while (0)
                    ROW2_LD(w0, e0); if (e1 >= 0) ROW2_LD(w1, e1); if (e2 >= 0) ROW2_LD(w2, e2); if (e3 >= 0) ROW2_LD(w3, e3);
                    ROW2_AC(w0); ROW2_AC(w1); ROW2_AC(w2); ROW2_AC(w3);
#undef ROW2_LD
#undef ROW2_AC
                }
                float s = 0.f;
#pragma unroll
                for (int j = 0; j < 4; ++j) s += (y[j].x * y[j].x + y[j].y * y[j].y) + (y[j].z * y[j].z + y[j].w * y[j].w);
                const float rstd = __builtin_amdgcn_rsqf(wave_sum(s) * (1.f / D) + NORM_EPS); float s2 = 0.f;
                f32x4g* xw = (f32x4g*)(XOUT + (size_t)m * D) + lane; f32x4g v[4];
#pragma unroll
                for (int j = 0; j < 4; ++j) { const int col = 4 * lane + 256 * j;
                    v[j] = xv[j] + (y[j] * rstd) * RPA[j];
                    if (l + 1 < DEPTH) { u32x2 w_; w_.x = pk2(v[j].x, v[j].y); w_.y = pk2(v[j].z, v[j].w); *(u32x2*)(xo_ + (size_t)m * D + col) = w_; } else xw[64 * j] = v[j];
                    s2 += (v[j].x * v[j].x + v[j].y * v[j].y) + (v[j].z * v[j].z + v[j].w * v[j].w); }
                if (l + 1 < DEPTH) { const float rstd2 = __builtin_amdgcn_rsqf(wave_sum(s2) * (1.f / D) + NORM_EPS);
#pragma unroll
                    for (int j = 0; j < 4; ++j) { const int col = 4 * lane + 256 * j; const f32x4g h = (v[j] * rstd2) * RPB[j] + RPS[j];
                        u32x2 w; w.x = pk2(h.x, h.y); w.y = pk2(h.z, h.w); *(u32x2*)(xno_ + (size_t)m * D + col) = w;
                        *(unsigned*)(XN8 + (size_t)m * D + col) = pg8::pk4_fp8(h.x, h.y, h.z, h.w); } }
              } }
            if (l + 1 < DEPTH && gw * 128 < M * 16) { unsigned z_ = 0u; asm volatile("" : "+v"(z_)); *(u32x2*)(KN2 + gw * 128 + 2 * lane) = (u32x2){z_, z_}; }
            SEAM(pb + 9);
        }
    }
#undef IN
#undef SEAM
}

extern "C" void kernel_launch(void* const* d_in, const int* in_sizes, int n_in, void* d_out, int out_size, void* d_ws, size_t ws_size, hipStream_t stream) {
    static int grid = 0;
    if (grid == 0) {
        if (n_in != 26 || in_sizes[0] != M * D || out_size != M * D || ws_size < WS_END) { fprintf(stderr, "kernel_launch: unexpected shapes (n_in %d, in0 %d, out %d, ws %zu < %zu); nothing launched\n", n_in, n_in > 0 ? in_sizes[0] : -1, out_size, ws_size, (size_t)WS_END); grid = -1; return; }
        int dev = 0, cus = 0, per_cu = 0;
        if (hipGetDevice(&dev) != hipSuccess || hipDeviceGetAttribute(&cus, hipDeviceAttributeMultiprocessorCount, dev) != hipSuccess) { grid = -1; return; }
        if (hipFuncSetAttribute((const void*)mk_fwd, hipFuncAttributeMaxDynamicSharedMemorySize, LDS_BYTES) != hipSuccess) { fprintf(stderr, "kernel_launch: hipFuncSetAttribute failed\n"); grid = -1; return; }
        if (hipOccupancyMaxActiveBlocksPerMultiprocessor(&per_cu, (const void*)mk_fwd, NWAVES * 64, LDS_BYTES) != hipSuccess || per_cu < 1) { fprintf(stderr, "kernel_launch: occupancy query says %d\n", per_cu); }
        (void)hipGetLastError();
        grid = 256;
        if (cus < 256) { fprintf(stderr, "kernel_launch: built for a 256-CU device (per-workgroup token lists hold 8 expert-GEMM units); %d CUs: nothing launched\n", cus); grid = -1; return; }
    }
    if (grid < 0) return;
    (void)hipMemsetAsync((char*)d_ws + WS_CTL, 0, CTL_ZERO_BYTES, stream);
    Args a{};
    for (int i = 0; i < 26; ++i) a.in[i] = (const float*)d_in[i];
    a.out = (float*)d_out; a.ws = (unsigned char*)d_ws; a.pad = 0;
#if MK_SINGLE
    a.ph_lo = 0; a.ph_hi = NPHASE; a.single = 1;
    hipLaunchKernelGGL(mk_fwd, dim3(grid), dim3(NWAVES * 64), LDS_BYTES, stream, a);
#else
    a.single = 0;
#ifndef MK_PROBE_STOP
#define MK_PROBE_STOP NPHASE
#endif
    for (int p = 0; p < MK_PROBE_STOP; ++p) { a.ph_lo = p; a.ph_hi = p + 1; hipLaunchKernelGGL(mk_fwd, dim3(grid), dim3(NWAVES * 64), LDS_BYTES, stream, a); }
#ifdef MK_PROBE_COPY_OFF
    (void)hipMemcpyAsync(d_out, (char*)d_ws + (MK_PROBE_COPY_OFF), (size_t)M * D * 4, hipMemcpyDeviceToDevice, stream);
#endif
#endif
}
```
